# Optimizing an MI355X kernel written in HIP

```python
import math
import jax, jax.numpy as jnp
from jax import lax
import numpy as np

D_MODEL = 1024
BATCH = 2
SEQ = 8192
DEPTH = 1

MEM_LEN = 256
ROPE_THETA = 10000.0
RMS_EPS = 1e-6
Q_BLOCK = 128

MLA_HEADS = 8
MLA_NOPE = 64
MLA_ROPE = 32
MLA_V = 64
MLA_Q_RANK = 256
MLA_KV_RANK = 128

SWA_HEADS = 8
SWA_KV_HEADS = 2
SWA_HEAD_DIM = 64
SWA_WINDOW = 128

XA_HEADS = 4
XA_HEAD_DIM = 128

N_EXPERTS = 32
TOP_K = 4
D_EXPERT = 1024
SWIGLU_ALPHA = 1.702
SWIGLU_LIMIT = 7.0
MOE_BLOCK = 128

N_BRANCHES = 3

COL_MLA_Q = MLA_Q_RANK
COL_MLA_KV = MLA_KV_RANK
COL_MLA_KR = MLA_ROPE
COL_SWA_Q = SWA_HEADS * SWA_HEAD_DIM
COL_SWA_K = SWA_KV_HEADS * SWA_HEAD_DIM
COL_SWA_V = SWA_KV_HEADS * SWA_HEAD_DIM
COL_XA_Q = XA_HEADS * XA_HEAD_DIM
COL_GATES = N_BRANCHES * D_MODEL
IN_SPLITS = (
    COL_MLA_Q,
    COL_MLA_Q + COL_MLA_KV,
    COL_MLA_Q + COL_MLA_KV + COL_MLA_KR,
    COL_MLA_Q + COL_MLA_KV + COL_MLA_KR + COL_SWA_Q,
    COL_MLA_Q + COL_MLA_KV + COL_MLA_KR + COL_SWA_Q + COL_SWA_K,
    COL_MLA_Q + COL_MLA_KV + COL_MLA_KR + COL_SWA_Q + COL_SWA_K + COL_SWA_V,
    COL_MLA_Q + COL_MLA_KV + COL_MLA_KR + COL_SWA_Q + COL_SWA_K + COL_SWA_V + COL_XA_Q,
)
D_IN_PROJ = COL_MLA_Q + COL_MLA_KV + COL_MLA_KR + COL_SWA_Q + COL_SWA_K + COL_SWA_V + COL_XA_Q + COL_GATES

kernel_name = "hybrid_mla_swa_xattn_moe_layer"


def rms_norm(x, g):
    xf = x.astype(jnp.float32)
    y = xf * lax.rsqrt(jnp.mean(xf * xf, axis=-1, keepdims=True) + RMS_EPS)
    return (y * g.astype(jnp.float32)).astype(x.dtype)


def rope(x, positions):
    d = x.shape[-1]
    inv_freq = ROPE_THETA ** (-jnp.arange(0, d, 2, dtype=jnp.float32) / d)
    ang = positions.astype(jnp.float32)[..., None] * inv_freq
    cos = jnp.cos(ang)[:, :, None, :]
    sin = jnp.sin(ang)[:, :, None, :]
    xf = x.astype(jnp.float32)
    x1, x2 = xf[..., : d // 2], xf[..., d // 2:]
    out = jnp.concatenate([x1 * cos - x2 * sin, x2 * cos + x1 * sin], axis=-1)
    return out.astype(x.dtype)


def mla_attention(q, k, v):
    b, s, h, dq = q.shape
    dv = v.shape[-1]
    nb = s // Q_BLOCK
    scale = 1.0 / math.sqrt(dq)
    qb = q.reshape(b, nb, Q_BLOCK, h, dq).transpose(1, 0, 2, 3, 4)
    kpos = jnp.arange(s)

    def block(args):
        q_blk, start = args
        sc = jnp.einsum('bqhd,bkhd->bhqk', q_blk, k).astype(jnp.float32) * scale
        qpos = start + jnp.arange(Q_BLOCK)
        sc = jnp.where(kpos[None, :] <= qpos[:, None], sc, -jnp.inf)
        p = jax.nn.softmax(sc, axis=-1).astype(v.dtype)
        return jnp.einsum('bhqk,bkhd->bqhd', p, v)

    o = lax.map(block, (qb, jnp.arange(nb) * Q_BLOCK))
    return o.transpose(1, 0, 2, 3, 4).reshape(b, s, h * dv)


def swa_attention(q, k, v, sinks):
    b, s, hq, dh = q.shape
    hkv = k.shape[2]
    grp = hq // hkv
    w = SWA_WINDOW
    nb = s // w
    scale = 1.0 / math.sqrt(dh)
    qb = q.reshape(b, nb, w, hkv, grp, dh)
    kb = k.reshape(b, nb, w, hkv, dh)
    vb = v.reshape(b, nb, w, hkv, dh)
    zpad = jnp.zeros_like(kb[:, :1])
    kk = jnp.concatenate([jnp.concatenate([zpad, kb[:, :-1]], axis=1), kb], axis=2)
    vv = jnp.concatenate([jnp.concatenate([zpad, vb[:, :-1]], axis=1), vb], axis=2)
    sc = jnp.einsum('bnqhgd,bnkhd->bnhgqk', qb, kk).astype(jnp.float32) * scale
    qi = jnp.arange(w)[:, None]
    kj = jnp.arange(2 * w)[None, :]
    diff = qi + w - kj
    band = (diff >= 0) & (diff < w)
    blk_ok = (jnp.arange(nb)[:, None, None] > 0) | (kj >= w)[None]
    mask = band[None] & blk_ok
    sc = jnp.where(mask[None, :, None, None], sc, -jnp.inf)
    sink = jnp.broadcast_to(sinks.astype(jnp.float32).reshape(1, 1, hkv, grp, 1, 1),
                            sc.shape[:-1] + (1,))
    p = jax.nn.softmax(jnp.concatenate([sc, sink], axis=-1), axis=-1)[..., :-1]
    o = jnp.einsum('bnhgqk,bnkhd->bnqhgd', p.astype(v.dtype), vv)
    return o.reshape(b, s, hq * dh)


def cross_attention(q, km, vm):
    scale = 1.0 / math.sqrt(q.shape[-1])
    sc = jnp.einsum('bshd,bmhd->bhsm', q, km).astype(jnp.float32) * scale
    p = jax.nn.softmax(sc, axis=-1).astype(vm.dtype)
    o = jnp.einsum('bhsm,bmhd->bshd', p, vm)
    return o.reshape(q.shape[0], q.shape[1], -1)


def moe_ffn(xt, w_router, b_router, w_gate_up, b_gate_up, w_down, b_down):
    t, d = xt.shape
    tk = t * TOP_K
    logits = (xt @ w_router + b_router).astype(jnp.float32)
    top_vals, top_idx = lax.top_k(logits, TOP_K)
    gates = jax.nn.softmax(top_vals, axis=-1).astype(xt.dtype)
    flat_e = top_idx.reshape(-1)
    order = jnp.argsort(flat_e)
    sorted_e = flat_e[order]
    counts = jax.ops.segment_sum(jnp.ones((tk,), jnp.int32), flat_e, num_segments=N_EXPERTS)
    padded = ((counts + MOE_BLOCK - 1) // MOE_BLOCK) * MOE_BLOCK
    padded_end = jnp.cumsum(padded)
    padded_start = padded_end - padded
    group_start = jnp.cumsum(counts) - counts
    rank = jnp.arange(tk) - group_start[sorted_e]
    dest = padded_start[sorted_e] + rank
    n_blocks = -(-tk // MOE_BLOCK) + N_EXPERTS
    n_rows = n_blocks * MOE_BLOCK
    token_of_row = jnp.full((n_rows,), t, jnp.int32).at[dest].set((order // TOP_K).astype(jnp.int32))
    weight_of_row = jnp.zeros((n_rows,), xt.dtype).at[dest].set(gates.reshape(-1)[order])
    block_expert = jnp.clip(jnp.searchsorted(padded_end, jnp.arange(n_blocks) * MOE_BLOCK, side='right'),
                            0, N_EXPERTS - 1)
    xpad = jnp.concatenate([xt, jnp.zeros((1, d), xt.dtype)], axis=0)

    def expert_block(args):
        rows, e = args
        xb = xpad[rows]
        gu = xb @ w_gate_up[e] + b_gate_up[e]
        x_glu = jnp.minimum(gu[:, :D_EXPERT], SWIGLU_LIMIT)
        x_lin = jnp.clip(gu[:, D_EXPERT:], -SWIGLU_LIMIT, SWIGLU_LIMIT)
        hdn = x_glu * jax.nn.sigmoid(SWIGLU_ALPHA * x_glu) * (x_lin + 1.0)
        return hdn @ w_down[e] + b_down[e]

    y = lax.map(expert_block, (token_of_row.reshape(n_blocks, MOE_BLOCK), block_expert))
    y = y.reshape(n_rows, d) * weight_of_row[:, None]
    out = jnp.zeros((t + 1, d), xt.dtype).at[token_of_row].add(y)
    return out[:t]


def setup_inputs(seed: int = 0) -> dict:
    key = jax.random.key(seed)
    ks = jax.random.split(key, 32)
    f32 = jnp.float32

    def w(k, shape, fan_in):
        return jax.random.normal(k, shape, f32) * (fan_in ** -0.5)

    def gain(k, shape):
        return 1.0 + 0.05 * jax.random.normal(k, shape, f32)

    def bias(k, shape):
        return 0.01 * jax.random.normal(k, shape, f32)

    L = DEPTH
    return {
        "x": jax.random.normal(ks[0], (BATCH, SEQ, D_MODEL), f32),
        "mem": jax.random.normal(ks[1], (BATCH, MEM_LEN, D_MODEL), f32),
        "positions": jnp.broadcast_to(jnp.arange(SEQ, dtype=jnp.int32), (BATCH, SEQ)),
        "g_mix": gain(ks[2], (L, D_MODEL)),
        "w_in": w(ks[3], (L, D_MODEL, D_IN_PROJ), D_MODEL),
        "g_mla_q": gain(ks[4], (L, MLA_Q_RANK)),
        "w_mla_uq": w(ks[5], (L, MLA_Q_RANK, MLA_HEADS * (MLA_NOPE + MLA_ROPE)), MLA_Q_RANK),
        "g_mla_kv": gain(ks[6], (L, MLA_KV_RANK)),
        "w_mla_ukv": w(ks[7], (L, MLA_KV_RANK, MLA_HEADS * (MLA_NOPE + MLA_V)), MLA_KV_RANK),
        "w_mla_o": w(ks[8], (L, MLA_HEADS * MLA_V, D_MODEL), MLA_HEADS * MLA_V),
        "swa_sinks": 0.5 * jax.random.normal(ks[9], (L, SWA_HEADS), f32),
        "w_swa_o": w(ks[10], (L, SWA_HEADS * SWA_HEAD_DIM, D_MODEL), SWA_HEADS * SWA_HEAD_DIM),
        "g_mem": gain(ks[11], (L, D_MODEL)),
        "w_mem_kv": w(ks[12], (L, D_MODEL, 2 * XA_HEADS * XA_HEAD_DIM), D_MODEL),
        "w_xa_o": w(ks[13], (L, XA_HEADS * XA_HEAD_DIM, D_MODEL), XA_HEADS * XA_HEAD_DIM),
        "b_gate": bias(ks[14], (L, COL_GATES)),
        "w_out": w(ks[15], (L, D_MODEL, D_MODEL), D_MODEL),
        "g_ffn": gain(ks[16], (L, D_MODEL)),
        "w_router": w(ks[17], (L, D_MODEL, N_EXPERTS), D_MODEL),
        "b_router": bias(ks[18], (L, N_EXPERTS)),
        "w_gate_up": w(ks[19], (L, N_EXPERTS, D_MODEL, 2 * D_EXPERT), D_MODEL),
        "b_gate_up": bias(ks[20], (L, N_EXPERTS, 2 * D_EXPERT)),
        "w_down": w(ks[21], (L, N_EXPERTS, D_EXPERT, D_MODEL), D_EXPERT),
        "b_down": bias(ks[22], (L, N_EXPERTS, D_MODEL)),
        "g_final": gain(ks[23], (D_MODEL,)),
    }


def reference(x, mem, positions, g_mix, w_in, g_mla_q, w_mla_uq, g_mla_kv, w_mla_ukv, w_mla_o,
              swa_sinks, w_swa_o, g_mem, w_mem_kv, w_xa_o, b_gate, w_out, g_ffn,
              w_router, b_router, w_gate_up, b_gate_up, w_down, b_down, g_final):
    b, s, d = x.shape
    h = x
    for l in range(DEPTH):
        xn = rms_norm(h, g_mix[l])
        proj = xn @ w_in[l]
        cq, ckv, kr, qs, kswa, vswa, qx, gate_logits = jnp.split(proj, IN_SPLITS, axis=-1)

        q_mla = (rms_norm(cq, g_mla_q[l]) @ w_mla_uq[l]).reshape(b, s, MLA_HEADS, MLA_NOPE + MLA_ROPE)
        q_mla = jnp.concatenate([q_mla[..., :MLA_NOPE], rope(q_mla[..., MLA_NOPE:], positions)], axis=-1)
        kv_mla = (rms_norm(ckv, g_mla_kv[l]) @ w_mla_ukv[l]).reshape(b, s, MLA_HEADS, MLA_NOPE + MLA_V)
        k_rope = jnp.broadcast_to(rope(kr[:, :, None, :], positions), (b, s, MLA_HEADS, MLA_ROPE))
        k_mla = jnp.concatenate([kv_mla[..., :MLA_NOPE], k_rope], axis=-1)
        v_mla = kv_mla[..., MLA_NOPE:]
        out_mla = mla_attention(q_mla, k_mla, v_mla) @ w_mla_o[l]

        q_swa = rope(qs.reshape(b, s, SWA_HEADS, SWA_HEAD_DIM), positions)
        k_swa = rope(kswa.reshape(b, s, SWA_KV_HEADS, SWA_HEAD_DIM), positions)
        v_swa = vswa.reshape(b, s, SWA_KV_HEADS, SWA_HEAD_DIM)
        out_swa = swa_attention(q_swa, k_swa, v_swa, swa_sinks[l]) @ w_swa_o[l]

        kv_mem = rms_norm(mem, g_mem[l]) @ w_mem_kv[l]
        m = mem.shape[1]
        k_mem = kv_mem[..., : XA_HEADS * XA_HEAD_DIM].reshape(b, m, XA_HEADS, XA_HEAD_DIM)
        v_mem = kv_mem[..., XA_HEADS * XA_HEAD_DIM:].reshape(b, m, XA_HEADS, XA_HEAD_DIM)
        out_xa = cross_attention(qx.reshape(b, s, XA_HEADS, XA_HEAD_DIM), k_mem, v_mem) @ w_xa_o[l]

        gates = jax.nn.sigmoid((gate_logits + b_gate[l]).astype(jnp.float32)).astype(x.dtype)
        gates = gates.reshape(b, s, N_BRANCHES, d)
        merged = gates[:, :, 0] * out_mla + gates[:, :, 1] * out_swa + gates[:, :, 2] * out_xa
        h = h + merged @ w_out[l]

        hn = rms_norm(h, g_ffn[l]).reshape(b * s, d)
        h = h + moe_ffn(hn, w_router[l], b_router[l], w_gate_up[l], b_gate_up[l],
                        w_down[l], b_down[l]).reshape(b, s, d)
    return rms_norm(h, g_final)
```

```cpp
#include <hip/hip_runtime.h>
#include <cstdio>
#include <cstdint>

#ifndef FAST_MASK
#define FAST_MASK 0x000u
#endif
#ifndef ONE_LAUNCH
#define ONE_LAUNCH 0
#endif

#define GAS __attribute__((address_space(1)))
#define LAS __attribute__((address_space(3)))
typedef unsigned short bf16;
typedef unsigned v4u __attribute__((ext_vector_type(4)));
typedef unsigned v2u __attribute__((ext_vector_type(2)));
typedef float f32x4 __attribute__((ext_vector_type(4)));
typedef short bf16x8 __attribute__((ext_vector_type(8)));
typedef GAS unsigned gu32;

constexpr int BATCH = 2, SEQ = 8192, M = BATCH * SEQ, D = 1024, MEML = 256, MROWS = BATCH * MEML;
constexpr int NPSRC = 4768;
constexpr int LDP = 4864;
constexpr int PC_CQ = 0, PC_CKV = 256, PC_KR = 384, PC_QS = 512, PC_KS = 1024, PC_VS = 1152, PC_QX = 1280, PC_G = 1792;
constexpr int SC_QX = 1184, SC_G = 1696;
constexpr int NE = 32, TOPK = 4, DE = 1024;
constexpr int RMAX = 73728;
constexpr int NCHUNK = M / 64;
constexpr float EPS = 1e-6f;
constexpr float LOG2E = 1.4426950408889634f;
constexpr float C_MLA = LOG2E * 0.10206207261596577f;
constexpr float C_SWA = LOG2E * 0.125f;
constexpr float C_XA = LOG2E * 0.08838834764831845f;

constexpr size_t MiB = 1u << 20;
constexpr size_t WS_CTL = 0, CTL_ZERO_BYTES = 1 * MiB;
constexpr size_t WS_WIN = 2 * MiB;
constexpr size_t WS_WUQ = 12 * MiB;
constexpr size_t WS_WUKV = 12 * MiB + 512 * 1024;
constexpr size_t WS_WMKV = 13 * MiB;
constexpr size_t WS_WO3 = 15 * MiB;
constexpr size_t WS_WOUT = 18 * MiB;
constexpr size_t WS_RMLA = 20 * MiB;
constexpr size_t WS_RSWA = 22 * MiB;
constexpr size_t WS_MEMN = 26 * MiB;
constexpr size_t WS_KVMEM = 27 * MiB;
constexpr size_t WS_TKE = 28 * MiB;
constexpr size_t WS_TKW = 28 * MiB + 256 * 1024;
constexpr size_t WS_TKR = 28 * MiB + 512 * 1024;
constexpr size_t WS_LRK = 28 * MiB + 768 * 1024;
constexpr size_t WS_ROWW = 29 * MiB;
constexpr size_t WS_CNT = 30 * MiB;
constexpr size_t WS_TILE = 30 * MiB + 64 * 1024;
constexpr size_t WS_WGU = 32 * MiB;
constexpr size_t WS_WDN = 160 * MiB;
constexpr size_t WS_XN = 224 * MiB;
constexpr size_t WS_H = 256 * MiB;
constexpr size_t WS_PROJ = 320 * MiB;
constexpr size_t WS_QMLA = 472 * MiB;
constexpr size_t WS_KVMLA = 496 * MiB;
constexpr size_t WS_ATT = 528 * MiB;
constexpr size_t WS_MERGED = 576 * MiB;
constexpr size_t WS_MERGEDB = 640 * MiB;
constexpr size_t WS_HDN = 472 * MiB;
constexpr size_t WS_END = 672 * MiB;
constexpr int CW_TMO = 0, CW_CODE = 1, CW_BAR = 4096;

constexpr int RING_BYTES = 131072;
constexpr int LDSCTL_OFF = RING_BYTES, MISC_OFF = LDSCTL_OFF + 320;
constexpr int SMALL_OFF = LDSCTL_OFF + 1024;
constexpr int LDS_BYTES = 147456;
constexpr int NWAVES = 8;

struct Args {
    const float *x, *mem; const int* pos;
    const float *g_mix, *w_in, *g_mla_q, *w_uq, *g_mla_kv, *w_ukv, *w_mla_o, *sinks, *w_swa_o, *g_mem, *w_mem_kv, *w_xa_o, *b_gate, *w_out, *g_ffn,
        *w_router, *b_router, *w_gu, *b_gu, *w_dn, *b_dn, *g_final;
    float* out; unsigned char* ws; int ph_lo, ph_hi;
};

#define RLX_AGENT __ATOMIC_RELAXED, __HIP_MEMORY_SCOPE_AGENT
#define LDS_WAIT() asm volatile("s_waitcnt lgkmcnt(0)" ::: "memory")
#define VM_WAIT() asm volatile("s_waitcnt vmcnt(0)" ::: "memory")
__device__ __forceinline__ unsigned f2bf(float f) { unsigned u = __builtin_bit_cast(unsigned, f); return (u + 0x7fffu + ((u >> 16) & 1u)) >> 16; }
__device__ __forceinline__ unsigned pk2(float lo, float hi) { return f2bf(lo) | (f2bf(hi) << 16); }
__device__ __forceinline__ float bf2f(unsigned v) { return __builtin_bit_cast(float, v << 16); }
__device__ __forceinline__ float bflo(unsigned w) { return __builtin_bit_cast(float, w << 16); }
__device__ __forceinline__ float bfhi(unsigned w) { return __builtin_bit_cast(float, w & 0xffff0000u); }
__device__ __forceinline__ float wave_sum(float v) {
#pragma unroll
    for (int o = 1; o < 64; o <<= 1) v += __shfl_xor(v, o);
    return v;
}

#define XB_TMO      128
#define XB_XCNT(j)  (256  + 64 * (j))
#define XB_XSUB(j)  (1280 + 64 * (j))
#define XB_XGEN(j)  (2304 + 64 * (j))
#define XB_TOP      3328
#define XB_TOPGEN   3392
#define XCD_BAR_WORDS 3456
#define XB_SPIN_CAP (1u << 18)
__device__ __forceinline__ unsigned xb_ld(unsigned* p)              { return __hip_atomic_load(p, __ATOMIC_RELAXED, __HIP_MEMORY_SCOPE_AGENT); }
__device__ __forceinline__ unsigned xb_add(unsigned* p, unsigned v) { return __hip_atomic_fetch_add(p, v, __ATOMIC_RELAXED, __HIP_MEMORY_SCOPE_AGENT); }
__device__ __forceinline__ unsigned xb_xcc_id() { return (unsigned)__builtin_amdgcn_s_getreg((3 << 11) | 20) & 0xFu; }
#define XB_SPIN(cond, bar) do { unsigned _sp = 0; while (cond) { __builtin_amdgcn_s_sleep(1); \
    if ((++_sp & 255u) == 0u) { if (xb_ld(&(bar)[XB_TMO])) break; if (_sp > XB_SPIN_CAP) { atomicAdd(&(bar)[XB_TMO], 1u); break; } } } } while (0)
struct XcdBarrier { unsigned* bar; unsigned x; volatile LAS unsigned* st; };
__device__ __forceinline__ XcdBarrier xcd_barrier_post(unsigned* bar, volatile LAS unsigned* st) {
    XcdBarrier b; b.bar = bar; b.x = xb_xcc_id(); b.st = st;
    if (threadIdx.x == 0) (void)xb_add(&bar[XB_XCNT(b.x)], 1u);
    return b;
}
__device__ __forceinline__ void xcd_barrier_complete(unsigned* bar, unsigned x, unsigned& nloc, unsigned& nx) {
    const unsigned G = gridDim.x * gridDim.y * gridDim.z;
    unsigned sum, cnt, mine, sp = 0u;
    for (;;) {
        sum = 0u; cnt = 0u; mine = 0u;
#pragma unroll
        for (unsigned j = 0; j < 16; ++j) { const unsigned c = xb_ld(&bar[XB_XCNT(j)]); sum += c; cnt += (c > 0u) ? 1u : 0u; mine = (j == x) ? c : mine; }
        if (sum == G) break;
        __builtin_amdgcn_s_sleep(1);
        if ((++sp & 255u) == 0u) { if (xb_ld(&bar[XB_TMO])) break; if (sp > XB_SPIN_CAP) { atomicAdd(&bar[XB_TMO], 1u); break; } }
    }
    nloc = mine > 0u ? mine : 1u; nx = cnt > 0u ? cnt : 1u;
}
__device__ __forceinline__ void xcd_barrier(const XcdBarrier& b) {
    asm volatile("s_waitcnt vmcnt(0)" ::: "memory");
    __syncthreads();
    if (threadIdx.x == 0) {
        unsigned* bar = b.bar;
        __builtin_amdgcn_s_waitcnt(0);
        unsigned nloc = b.st[0], nx = b.st[1];
        if (nloc == 0u) { xcd_barrier_complete(bar, b.x, nloc, nx); b.st[0] = nloc; b.st[1] = nx; }
        const unsigned old = xb_add(&bar[XB_XSUB(b.x)], 1u);
        const unsigned gen = old / nloc;
        if (old + 1u == (gen + 1u) * nloc) {
            __builtin_amdgcn_fence(__ATOMIC_RELEASE, "agent");
            asm volatile("s_waitcnt vmcnt(0)" ::: "memory");
            const unsigned og = xb_add(&bar[XB_TOP], 1u);
            const unsigned tg = og / nx;
            if (og + 1u == (tg + 1u) * nx) xb_add(&bar[XB_TOPGEN], 1u);
            else XB_SPIN(xb_ld(&bar[XB_TOPGEN]) == tg, bar);
            __builtin_amdgcn_fence(__ATOMIC_ACQUIRE, "agent");
            xb_add(&bar[XB_XGEN(b.x)], 1u);
            asm volatile("s_waitcnt vmcnt(0)" ::: "memory");
        } else {
            XB_SPIN(xb_ld(&bar[XB_XGEN(b.x)]) == gen, bar);
            __builtin_amdgcn_fence(__ATOMIC_ACQUIRE, "agent");
            asm volatile("s_waitcnt vmcnt(0)" ::: "memory");
        }
    }
    __syncthreads();
}

struct Frame {
    LAS unsigned char* lds;
    volatile LAS unsigned* MISC;
    gu32* ctl;
    int tid, lane, wave, vcu, G;
    unsigned char* ws;
};
#define WSP(T, off) ((T*)(F.ws + (off)))

__device__ __forceinline__ void rms_row_to_bf16(const float* xrow, const float* g, bf16* orow, int lane) {
    const GAS f32x4* xr = (const GAS f32x4*)xrow + lane; const GAS f32x4* gr = (const GAS f32x4*)g + lane;
    f32x4 v[4]; float s = 0.f;
#pragma unroll
    for (int j = 0; j < 4; ++j) { v[j] = xr[64 * j]; s += (v[j].x * v[j].x + v[j].y * v[j].y) + (v[j].z * v[j].z + v[j].w * v[j].w); }
    const float rstd = 1.f / sqrtf(wave_sum(s) * (1.f / D) + EPS);
    GAS unsigned long long* o8 = (GAS unsigned long long*)orow + lane;
#pragma unroll
    for (int j = 0; j < 4; ++j) { const f32x4 gg = gr[64 * j];
        o8[64 * j] = (unsigned long long)pk2(v[j].x * rstd * gg.x, v[j].y * rstd * gg.y) | ((unsigned long long)pk2(v[j].z * rstd * gg.z, v[j].w * rstd * gg.w) << 32); }
}
__device__ __forceinline__ void p0_transpose_item(const float* W, int ldw, int src_n0, int k0, bf16* WT, int K, int dst_row0, LAS float* scr, int lane) {
#pragma unroll 8
    for (int i = 0; i < 32; ++i) { const int kk = 2 * i + (lane >> 5); scr[kk * 33 + (lane & 31)] = src_n0 >= 0 ? W[(size_t)(k0 + kk) * ldw + src_n0 + (lane & 31)] : 0.f; }
    LDS_WAIT(); asm volatile("" ::: "memory");
    const int c = lane & 7;
#pragma unroll
    for (int j = 0; j < 4; ++j) { const int n = (lane >> 3) + 8 * j; const LAS float* s = scr + (8 * c) * 33 + n;
        v4u o; o.x = pk2(s[0 * 33], s[1 * 33]); o.y = pk2(s[2 * 33], s[3 * 33]); o.z = pk2(s[4 * 33], s[5 * 33]); o.w = pk2(s[6 * 33], s[7 * 33]);
        *(GAS v4u*)(WT + (size_t)(dst_row0 + n) * K + k0 + 8 * c) = o; }
    LDS_WAIT(); asm volatile("" ::: "memory");
}
__device__ __forceinline__ void p0_prologue(Frame& F, const Args& a) {
    const int gw = F.vcu * NWAVES + F.wave, NGW = F.G * NWAVES;
    if (FAST_MASK != 0u) {
        LAS float* scr = (LAS float*)(F.lds + F.wave * 16384);
        constexpr int I_IN = 16 * 152, I_UQ = 4 * 24, I_UKV = 2 * 32, I_MKV = 16 * 32, I_O = 8 * 32, I_OUT = 16 * 32, I_GU = 16 * 64, I_DN = 16 * 32;
        constexpr int NITEMS = I_IN + I_UQ + I_UKV + I_MKV + 3 * I_O + I_OUT + NE * I_GU + NE * I_DN;
        for (int it = gw; it < NITEMS; it += NGW) {
            int r = it;
            if (r < I_IN) { const int kb = r / 152, nb = r % 152, n0 = nb * 32; const int src = n0 < 416 ? n0 : (n0 < 512 ? -1 : n0 - 96);
                p0_transpose_item(a.w_in, NPSRC, src, kb * 64, WSP(bf16, WS_WIN), 1024, n0, scr, F.lane); continue; } r -= I_IN;
            if (r < I_UQ) { const int kb = r / 24, nb = r % 24; p0_transpose_item(a.w_uq, 768, nb * 32, kb * 64, WSP(bf16, WS_WUQ), 256, nb * 32, scr, F.lane); continue; } r -= I_UQ;
            if (r < I_UKV) { const int kb = r / 32, nb = r % 32; p0_transpose_item(a.w_ukv, 1024, nb * 32, kb * 64, WSP(bf16, WS_WUKV), 128, nb * 32, scr, F.lane); continue; } r -= I_UKV;
            if (r < I_MKV) { const int kb = r / 32, nb = r % 32; p0_transpose_item(a.w_mem_kv, 1024, nb * 32, kb * 64, WSP(bf16, WS_WMKV), 1024, nb * 32, scr, F.lane); continue; } r -= I_MKV;
            if (r < 3 * I_O) { const int b = r / I_O, q = r % I_O, kb = q / 32, nb = q % 32; const float* w = b == 0 ? a.w_mla_o : (b == 1 ? a.w_swa_o : a.w_xa_o);
                p0_transpose_item(w, 1024, nb * 32, kb * 64, WSP(bf16, WS_WO3), 512, b * 1024 + nb * 32, scr, F.lane); continue; } r -= 3 * I_O;
            if (r < I_OUT) { const int kb = r / 32, nb = r % 32; p0_transpose_item(a.w_out, 1024, nb * 32, kb * 64, WSP(bf16, WS_WOUT), 1024, nb * 32, scr, F.lane); continue; } r -= I_OUT;
            if (r < NE * I_GU) { const int e = r / I_GU, q = r % I_GU, kb = q / 64, nb = q % 64, n0 = nb * 32, pn = n0 >> 8, j = n0 & 255;
                const int src = j < 128 ? 128 * pn + j : 1024 + 128 * pn + (j - 128);
                p0_transpose_item(a.w_gu + (size_t)e * 1024 * 2048, 2048, src, kb * 64, WSP(bf16, WS_WGU), 1024, e * 2048 + n0, scr, F.lane); continue; } r -= NE * I_GU;
            { const int e = r / I_DN, q = r % I_DN, kb = q / 32, nb = q % 32;
              p0_transpose_item(a.w_dn + (size_t)e * 1024 * 1024, 1024, nb * 32, kb * 64, WSP(bf16, WS_WDN), 1024, e * 1024 + nb * 32, scr, F.lane); }
        }
    }
    for (int m = gw; m < M; m += NGW) rms_row_to_bf16(a.x + (size_t)m * D, a.g_mix, WSP(bf16, WS_XN) + (size_t)m * D, F.lane);
    for (int m = gw; m < MROWS; m += NGW) rms_row_to_bf16(a.mem + (size_t)m * D, a.g_mem, WSP(bf16, WS_MEMN) + (size_t)m * D, F.lane);
    for (int m = gw; m < M; m += NGW) {
        if (F.lane < 48) {
            const bool mla = F.lane < 16; const int i = mla ? F.lane : F.lane - 16;
            const float inv = powf(10000.f, mla ? -(float)(2 * i) / 32.f : -(float)(2 * i) / 64.f);
            const float ang = (float)a.pos[m] * inv;
            float sn, cs; sincosf(ang, &sn, &cs);
            float* dst = mla ? WSP(float, WS_RMLA) + ((size_t)m * 16 + i) * 2 : WSP(float, WS_RSWA) + ((size_t)m * 32 + i) * 2;
            dst[0] = cs; dst[1] = sn;
        }
    }
}

__device__ __forceinline__ void p2_token_local(Frame& F, const Args& a) {
    const int gw = F.vcu * NWAVES + F.wave, NGW = F.G * NWAVES, lane = F.lane;
    for (int m = gw; m < M; m += NGW) {
        bf16* pr = WSP(bf16, WS_PROJ) + (size_t)m * LDP;
        {
            const v2u w = *(const v2u*)(pr + PC_CQ + 4 * lane);
            float v0 = bflo(w.x), v1 = bfhi(w.x), v2 = bflo(w.y), v3 = bfhi(w.y);
            const float rstd = 1.f / sqrtf(wave_sum(v0 * v0 + v1 * v1 + v2 * v2 + v3 * v3) * (1.f / 256.f) + EPS);
            const f32x4 g = *(const f32x4*)(a.g_mla_q + 4 * lane);
            v2u o; o.x = pk2(v0 * rstd * g.x, v1 * rstd * g.y); o.y = pk2(v2 * rstd * g.z, v3 * rstd * g.w);
            *(v2u*)(pr + PC_CQ + 4 * lane) = o;
        }
        {
            const unsigned w = *(const unsigned*)(pr + PC_CKV + 2 * lane);
            float v0 = bflo(w), v1 = bfhi(w);
            const float rstd = 1.f / sqrtf(wave_sum(v0 * v0 + v1 * v1) * (1.f / 128.f) + EPS);
            *(unsigned*)(pr + PC_CKV + 2 * lane) = pk2(v0 * rstd * a.g_mla_kv[2 * lane], v1 * rstd * a.g_mla_kv[2 * lane + 1]);
        }
        if (lane < 16) {
            const float x1 = bf2f(pr[PC_KR + lane]), x2 = bf2f(pr[PC_KR + 16 + lane]);
            const float* t = WSP(float, WS_RMLA) + ((size_t)m * 16 + lane) * 2; const float c = t[0], s = t[1];
            pr[PC_KR + lane] = (bf16)f2bf(x1 * c - x2 * s); pr[PC_KR + 16 + lane] = (bf16)f2bf(x2 * c + x1 * s);
        }
        const int i = lane & 31;
        const float* t = WSP(float, WS_RSWA) + ((size_t)m * 32 + i) * 2; const float c = t[0], s = t[1];
#pragma unroll
        for (int j = 0; j < 4; ++j) {
            const int h = (lane + 64 * j) >> 5; bf16* q = pr + PC_QS + h * 64 + i;
            const float x1 = bf2f(q[0]), x2 = bf2f(q[32]);
            q[0] = (bf16)f2bf((x1 * c - x2 * s) * C_SWA); q[32] = (bf16)f2bf((x2 * c + x1 * s) * C_SWA);
        }
        {
            bf16* k = pr + PC_KS + (lane >> 5) * 64 + i;
            const float x1 = bf2f(k[0]), x2 = bf2f(k[32]);
            k[0] = (bf16)f2bf(x1 * c - x2 * s); k[32] = (bf16)f2bf(x2 * c + x1 * s);
        }
    }
}

__device__ __forceinline__ void p7_router(Frame& F, const Args& a) {
    const int lane = F.lane, wave = F.wave, tid = F.tid;
    LAS float* hs = (LAS float*)(F.lds) + wave * 4096;
    LAS int* e_arr = (LAS int*)(F.lds + SMALL_OFF);
    const float* H = WSP(float, WS_H);
    for (int c = F.vcu; c < NCHUNK; c += F.G) {
        for (int r = 0; r < 2; ++r) {
            const int tl0 = wave * 8 + r * 4;
#pragma unroll
            for (int q = 0; q < 4; ++q) {
                const int t = c * 64 + tl0 + q;
                const GAS f32x4* xr = (const GAS f32x4*)(H + (size_t)t * D) + lane; const GAS f32x4* gr = (const GAS f32x4*)a.g_ffn + lane;
                f32x4 v[4]; float s = 0.f;
#pragma unroll
                for (int j = 0; j < 4; ++j) { v[j] = xr[64 * j]; s += (v[j].x * v[j].x + v[j].y * v[j].y) + (v[j].z * v[j].z + v[j].w * v[j].w); }
                const float rstd = 1.f / sqrtf(wave_sum(s) * (1.f / D) + EPS);
                GAS unsigned long long* o8 = (GAS unsigned long long*)(WSP(bf16, WS_XN) + (size_t)t * D) + lane;
#pragma unroll
                for (int j = 0; j < 4; ++j) { const f32x4 gg = gr[64 * j]; f32x4 y; y.x = v[j].x * rstd * gg.x; y.y = v[j].y * rstd * gg.y; y.z = v[j].z * rstd * gg.z; y.w = v[j].w * rstd * gg.w;
                    o8[64 * j] = (unsigned long long)pk2(y.x, y.y) | ((unsigned long long)pk2(y.z, y.w) << 32);
                    *(LAS f32x4*)(hs + q * 1024 + 4 * (64 * j + lane)) = y; }
            }
            LDS_WAIT(); asm volatile("" ::: "memory");
            const int e = lane & 31, half = lane >> 5;
            float acc[4] = {0.f, 0.f, 0.f, 0.f};
            const float* wr = a.w_router + (size_t)(half * 512) * NE + e;
            const LAS float* hh = hs + half * 512;
#pragma unroll 4
            for (int kk = 0; kk < 512; ++kk) { const float w = wr[(size_t)kk * NE];
#pragma unroll
                for (int q = 0; q < 4; ++q) acc[q] += hh[q * 1024 + kk] * w; }
            const float br = a.b_router[e];
#pragma unroll
            for (int q = 0; q < 4; ++q) {
                float lg = acc[q] + __shfl_xor(acc[q], 32) + br;
                float tv[4]; int ti[4];
#pragma unroll
                for (int k = 0; k < 4; ++k) {
                    float v = lg; int idx = e;
#pragma unroll
                    for (int o = 1; o < 32; o <<= 1) { const float ov = __shfl_xor(v, o); const int oi = __shfl_xor(idx, o); if (ov > v || (ov == v && oi < idx)) { v = ov; idx = oi; } }
                    tv[k] = v; ti[k] = idx; if (e == idx) lg = -INFINITY;
                }
                const float e1 = __expf(tv[1] - tv[0]), e2 = __expf(tv[2] - tv[0]), e3 = __expf(tv[3] - tv[0]); const float inv = 1.f / (1.f + e1 + e2 + e3);
                if (lane == 0) { const int tl = tl0 + q; const int t = c * 64 + tl;
                    int* te = WSP(int, WS_TKE) + (size_t)t * 4; float* tw = WSP(float, WS_TKW) + (size_t)t * 4;
                    te[0] = ti[0]; te[1] = ti[1]; te[2] = ti[2]; te[3] = ti[3]; tw[0] = inv; tw[1] = e1 * inv; tw[2] = e2 * inv; tw[3] = e3 * inv;
                    e_arr[tl * 4 + 0] = ti[0]; e_arr[tl * 4 + 1] = ti[1]; e_arr[tl * 4 + 2] = ti[2]; e_arr[tl * 4 + 3] = ti[3]; }
            }
            LDS_WAIT(); asm volatile("" ::: "memory");
        }
        __syncthreads();
        if (tid < 256) { const int e = e_arr[tid]; int rk = 0; for (int j = 0; j < tid; ++j) rk += (e_arr[j] == e) ? 1 : 0; WSP(int, WS_LRK)[(size_t)c * 256 + tid] = rk; }
        else if (tid < 256 + NE) { const int e = tid - 256; int n = 0; for (int j = 0; j < 256; ++j) n += (e_arr[j] == e) ? 1 : 0; WSP(int, WS_CNT)[c * NE + e] = n; }
        __syncthreads();
    }
}

__device__ __forceinline__ void p8_gather(Frame& F, const Args& a) {
    const int lane = F.lane, wave = F.wave, tid = F.tid;
    LAS int* cs = (LAS int*)(F.lds);
    LAS int* pre = (LAS int*)(F.lds + SMALL_OFF);
    LAS int* tot = pre + 32; LAS int* pst = pre + 64;
    bf16* XG = WSP(bf16, WS_PROJ); const bf16* HN = WSP(bf16, WS_XN);
    for (int c = F.vcu; c < NCHUNK; c += F.G) {
        for (int i = tid; i < NCHUNK * NE; i += NWAVES * 64) cs[i] = WSP(int, WS_CNT)[i];
        __syncthreads();
        if (tid < NE) { int p = 0, t = 0; for (int cc = 0; cc < NCHUNK; ++cc) { const int v = cs[cc * NE + tid]; if (cc < c) p += v; t += v; } pre[tid] = p; tot[tid] = t; }
        __syncthreads();
        if (tid == 0) { int ps = 0; for (int e = 0; e < NE; ++e) { pst[e] = ps; const int np = (tot[e] + 255) & ~255;
                if (c == 0) for (int tl = ps >> 8; tl < (ps + np) >> 8; ++tl) WSP(int, WS_TILE)[64 + tl] = e;
                ps += np; }
            if (c == 0) WSP(int, WS_TILE)[0] = ps >> 8; }
        __syncthreads();
        for (int i = wave * 32; i < wave * 32 + 32; ++i) {
            const int t = c * 64 + (i >> 2), k = i & 3;
            const int e = WSP(int, WS_TKE)[(size_t)t * 4 + k];
            const int row = pst[e] + pre[e] + WSP(int, WS_LRK)[(size_t)c * 256 + i];
            const GAS v4u* src = (const GAS v4u*)(HN + (size_t)t * D); GAS v4u* dst = (GAS v4u*)(XG + (size_t)row * D);
            const v4u x0 = src[lane], x1 = src[64 + lane]; dst[lane] = x0; dst[64 + lane] = x1;
            if (lane == 0) { WSP(float, WS_ROWW)[row] = WSP(float, WS_TKW)[(size_t)t * 4 + k]; WSP(int, WS_TKR)[(size_t)t * 4 + k] = row; }
        }
        __syncthreads();
    }
}

__device__ __forceinline__ void p11_combine(Frame& F, const Args& a) {
    const int gw = F.vcu * NWAVES + F.wave, NGW = F.G * NWAVES, lane = F.lane;
    const bf16* Y = WSP(bf16, WS_PROJ);
    for (int m = gw; m < M; m += NGW) {
        const GAS f32x4* xr = (const GAS f32x4*)(WSP(float, WS_H) + (size_t)m * D) + lane; const GAS f32x4* gr = (const GAS f32x4*)a.g_final + lane;
        f32x4 v[4];
#pragma unroll
        for (int j = 0; j < 4; ++j) v[j] = xr[64 * j];
#pragma unroll
        for (int k = 0; k < 4; ++k) { const int row = WSP(int, WS_TKR)[(size_t)m * 4 + k]; const GAS v2u* yr = (const GAS v2u*)(Y + (size_t)row * D) + lane;
#pragma unroll
            for (int j = 0; j < 4; ++j) { const v2u w = yr[64 * j]; v[j].x += bflo(w.x); v[j].y += bfhi(w.x); v[j].z += bflo(w.y); v[j].w += bfhi(w.y); } }
        float s = 0.f;
#pragma unroll
        for (int j = 0; j < 4; ++j) s += (v[j].x * v[j].x + v[j].y * v[j].y) + (v[j].z * v[j].z + v[j].w * v[j].w);
        const float rstd = 1.f / sqrtf(wave_sum(s) * (1.f / D) + EPS);
        GAS f32x4* o = (GAS f32x4*)(a.out + (size_t)m * D) + lane;
#pragma unroll
        for (int j = 0; j < 4; ++j) { const f32x4 gg = gr[64 * j]; f32x4 y; y.x = v[j].x * rstd * gg.x; y.y = v[j].y * rstd * gg.y; y.z = v[j].z * rstd * gg.z; y.w = v[j].w * rstd * gg.w; o[64 * j] = y; }
    }
}

__global__ void __launch_bounds__(NWAVES * 64, 2) fwd(Args args) {
    extern __shared__ __attribute__((aligned(16))) unsigned char lds[];
    Frame F;
    F.lds = (LAS unsigned char*)lds;
    F.MISC = (volatile LAS unsigned*)(F.lds + MISC_OFF);
    F.tid = threadIdx.x; F.lane = F.tid & 63; F.wave = __builtin_amdgcn_readfirstlane(F.tid >> 6);
    F.G = gridDim.x; { const int bx = blockIdx.x; F.vcu = (F.G % 8 == 0) ? (bx % 8) * (F.G / 8) + bx / 8 : bx; }
    F.ws = args.ws; F.ctl = (gu32*)(args.ws + WS_CTL);
    for (int u = F.tid; u < (LDS_BYTES - LDSCTL_OFF) / 4; u += NWAVES * 64) ((LAS unsigned*)(F.lds + LDSCTL_OFF))[u] = 0u;
    __syncthreads();
    const int lo = args.ph_lo, hi = args.ph_hi;
    XcdBarrier bar; bar.bar = (unsigned*)(F.ctl + CW_BAR) + lo * XCD_BAR_WORDS; bar.x = 0; bar.st = nullptr;
    if (hi - lo > 1) bar = xcd_barrier_post((unsigned*)(F.ctl + CW_BAR) + lo * XCD_BAR_WORDS, F.MISC + 8);
#define IN(k) (lo <= (k) && (k) < hi)
#define SEAM(k) do { if (IN(k) && IN((k) + 1)) xcd_barrier(bar); } while (0)
    if (IN(0)) { p0_prologue(F, args); SEAM(0); }
    if (IN(1)) { SEAM(1); }
    if (IN(2)) { p2_token_local(F, args); SEAM(2); }
    if (IN(3)) { SEAM(3); }
    if (IN(4)) { SEAM(4); }
    if (IN(5)) { SEAM(5); }
    if (IN(6)) { SEAM(6); }
    if (IN(7)) { p7_router(F, args); SEAM(7); }
    if (IN(8)) { p8_gather(F, args); SEAM(8); }
    if (IN(9)) { SEAM(9); }
    if (IN(10)) { SEAM(10); }
    if (IN(11)) { p11_combine(F, args); }
#undef IN
#undef SEAM
}

__device__ __forceinline__ void nv_tile(const bf16* A, int lda, int row0, int nrows, const float* W, int ldw, int col0, int ncols, int K, float (&acc)[4][4], float* As, float* Ws) {
    const int tid = threadIdx.x, ty = tid >> 4, tx = tid & 15;
    for (int k0 = 0; k0 < K; k0 += 16) {
        { const int r = row0 + (tid >> 2), kq = (tid & 3) * 4; v2u w; w.x = 0u; w.y = 0u; if (r < nrows) w = *(const v2u*)(A + (size_t)r * lda + k0 + kq);
          As[(kq + 0) * 68 + (tid >> 2)] = bflo(w.x); As[(kq + 1) * 68 + (tid >> 2)] = bfhi(w.x); As[(kq + 2) * 68 + (tid >> 2)] = bflo(w.y); As[(kq + 3) * 68 + (tid >> 2)] = bfhi(w.y); }
        { const int kk = tid >> 4, c4 = (tid & 15) * 4; f32x4 w = {0.f, 0.f, 0.f, 0.f}; if (col0 + c4 < ncols) w = *(const f32x4*)(W + (size_t)(k0 + kk) * ldw + col0 + c4);
          *(f32x4*)(Ws + kk * 64 + c4) = w; }
        __syncthreads();
#pragma unroll
        for (int kk = 0; kk < 16; ++kk) { const f32x4 av = *(const f32x4*)(As + kk * 68 + ty * 4); const f32x4 bv = *(const f32x4*)(Ws + kk * 64 + tx * 4);
#pragma unroll
            for (int i = 0; i < 4; ++i)
#pragma unroll
                for (int j = 0; j < 4; ++j) acc[i][j] += av[i] * bv[j]; }
        __syncthreads();
    }
}
#define NV_ZERO(acc) do { _Pragma("unroll") for (int i_ = 0; i_ < 4; ++i_) _Pragma("unroll") for (int j_ = 0; j_ < 4; ++j_) acc[i_][j_] = 0.f; } while (0)
enum { NV_PROJ = 1, NV_KVMEM, NV_QMLA, NV_KVMLA, NV_OUT3, NV_WOUT, NV_GU, NV_DN };
template <int ST> __global__ void __launch_bounds__(256) nv_gemm(Args a) {
    __shared__ __attribute__((aligned(16))) float As[16 * 68]; __shared__ __attribute__((aligned(16))) float Ws[16 * 64];
    unsigned char* ws = a.ws;
    const int tid = threadIdx.x, ty = tid >> 4, tx = tid & 15, row0 = blockIdx.y * 64, col0 = blockIdx.x * 64;
    float acc[4][4]; NV_ZERO(acc);
    if constexpr (ST == NV_PROJ) {
        nv_tile((const bf16*)(ws + WS_XN), D, row0, M, a.w_in, NPSRC, col0, NPSRC, D, acc, As, Ws);
        bf16* P = (bf16*)(ws + WS_PROJ);
        for (int i = 0; i < 4; ++i) for (int j = 0; j < 4; ++j) { const int r = row0 + ty * 4 + i, sc = col0 + tx * 4 + j; if (sc >= NPSRC) continue;
            float v = acc[i][j]; if (sc >= SC_G) v = 1.f / (1.f + __expf(-(v + a.b_gate[sc - SC_G]))); else if (sc >= SC_QX) v *= C_XA;
            P[(size_t)r * LDP + (sc < 416 ? sc : sc + 96)] = (bf16)f2bf(v); }
    } else if constexpr (ST == NV_KVMEM) {
        nv_tile((const bf16*)(ws + WS_MEMN), D, row0, MROWS, a.w_mem_kv, 1024, col0, 1024, D, acc, As, Ws);
        bf16* O = (bf16*)(ws + WS_KVMEM);
        for (int i = 0; i < 4; ++i) for (int j = 0; j < 4; ++j) O[(size_t)(row0 + ty * 4 + i) * 1024 + col0 + tx * 4 + j] = (bf16)f2bf(acc[i][j]);
    } else if constexpr (ST == NV_QMLA) {
        nv_tile((const bf16*)(ws + WS_PROJ) + PC_CQ, LDP, row0, M, a.w_uq, 768, col0, 768, 256, acc, As, Ws);
        bf16* O = (bf16*)(ws + WS_QMLA);
        for (int i = 0; i < 4; ++i) for (int j = 0; j < 4; ++j) O[(size_t)(row0 + ty * 4 + i) * 768 + col0 + tx * 4 + j] = (bf16)f2bf(acc[i][j] * C_MLA);
    } else if constexpr (ST == NV_KVMLA) {
        nv_tile((const bf16*)(ws + WS_PROJ) + PC_CKV, LDP, row0, M, a.w_ukv, 1024, col0, 1024, 128, acc, As, Ws);
        bf16* O = (bf16*)(ws + WS_KVMLA);
        for (int i = 0; i < 4; ++i) for (int j = 0; j < 4; ++j) O[(size_t)(row0 + ty * 4 + i) * 1024 + col0 + tx * 4 + j] = (bf16)f2bf(acc[i][j]);
    } else if constexpr (ST == NV_OUT3) {
        float tot[4][4]; NV_ZERO(tot);
        const bf16* P = (const bf16*)(ws + WS_PROJ);
        for (int b = 0; b < 3; ++b) {
            NV_ZERO(acc);
            const float* w = b == 0 ? a.w_mla_o : (b == 1 ? a.w_swa_o : a.w_xa_o);
            nv_tile((const bf16*)(ws + WS_ATT) + b * 512, 1536, row0, M, w, 1024, col0, 1024, 512, acc, As, Ws);
            for (int i = 0; i < 4; ++i) for (int j = 0; j < 4; ++j) tot[i][j] += acc[i][j] * bf2f(P[(size_t)(row0 + ty * 4 + i) * LDP + PC_G + b * 1024 + col0 + tx * 4 + j]);
        }
        bf16* O = (bf16*)(ws + WS_MERGEDB);
        for (int i = 0; i < 4; ++i) for (int j = 0; j < 4; ++j) O[(size_t)(row0 + ty * 4 + i) * 1024 + col0 + tx * 4 + j] = (bf16)f2bf(tot[i][j]);
    } else if constexpr (ST == NV_WOUT) {
        nv_tile((const bf16*)(ws + WS_MERGEDB), 1024, row0, M, a.w_out, 1024, col0, 1024, 1024, acc, As, Ws);
        float* O = (float*)(ws + WS_H);
        for (int i = 0; i < 4; ++i) for (int j = 0; j < 4; ++j) { const size_t o = (size_t)(row0 + ty * 4 + i) * 1024 + col0 + tx * 4 + j; O[o] = a.x[o] + acc[i][j]; }
    } else if constexpr (ST == NV_GU) {
        const int* tile = (const int*)(ws + WS_TILE); const int nt = tile[0]; if (row0 >= nt * 256) return;
        const int e = tile[64 + (row0 >> 8)];
        float acl[4][4]; NV_ZERO(acl);
        const float* w = a.w_gu + (size_t)e * 1024 * 2048;
        nv_tile((const bf16*)(ws + WS_PROJ), 1024, row0, RMAX, w, 2048, col0, 2048, 1024, acc, As, Ws);
        nv_tile((const bf16*)(ws + WS_PROJ), 1024, row0, RMAX, w, 2048, 1024 + col0, 2048, 1024, acl, As, Ws);
        bf16* O = (bf16*)(ws + WS_HDN);
        for (int i = 0; i < 4; ++i) for (int j = 0; j < 4; ++j) { const int c = col0 + tx * 4 + j;
            const float g = fminf(acc[i][j] + a.b_gu[e * 2048 + c], 7.f), l = fminf(fmaxf(acl[i][j] + a.b_gu[e * 2048 + 1024 + c], -7.f), 7.f);
            O[(size_t)(row0 + ty * 4 + i) * 1024 + c] = (bf16)f2bf(g / (1.f + __expf(-1.702f * g)) * (l + 1.f)); }
    } else if constexpr (ST == NV_DN) {
        const int* tile = (const int*)(ws + WS_TILE); const int nt = tile[0]; if (row0 >= nt * 256) return;
        const int e = tile[64 + (row0 >> 8)];
        nv_tile((const bf16*)(ws + WS_HDN), 1024, row0, RMAX, a.w_dn + (size_t)e * 1024 * 1024, 1024, col0, 1024, 1024, acc, As, Ws);
        bf16* O = (bf16*)(ws + WS_PROJ); const float* rw = (const float*)(ws + WS_ROWW);
        for (int i = 0; i < 4; ++i) for (int j = 0; j < 4; ++j) { const int r = row0 + ty * 4 + i, c = col0 + tx * 4 + j;
            O[(size_t)r * 1024 + c] = (bf16)f2bf((acc[i][j] + a.b_dn[e * 1024 + c]) * rw[r]); }
    }
}

template <int MODE> __global__ void __launch_bounds__(128) nv_attn(Args a) {
    constexpr int DQK = MODE == 0 ? 96 : (MODE == 1 ? 64 : 128), DV = 64;
    __shared__ float Ks[32 * DQK]; __shared__ float Vs[32 * DV];
    unsigned char* ws = a.ws;
    const bf16* PROJ = (const bf16*)(ws + WS_PROJ); const bf16* KVMLA = (const bf16*)(ws + WS_KVMLA); const bf16* KVMEM = (const bf16*)(ws + WS_KVMEM); const bf16* QMLA = (const bf16*)(ws + WS_QMLA);
    const int tid = threadIdx.x, b = blockIdx.z, q0 = blockIdx.x * 128, qi = q0 + tid; const size_t m = (size_t)b * SEQ + qi;
    const int h = MODE == 2 ? blockIdx.y >> 1 : blockIdx.y, vh = MODE == 2 ? (blockIdx.y & 1) : 0;
    float q[DQK];
    if constexpr (MODE == 0) {
#pragma unroll
        for (int d = 0; d < 64; ++d) q[d] = bf2f(QMLA[m * 768 + h * 96 + d]);
#pragma unroll
        for (int i = 0; i < 16; ++i) { const float x1 = bf2f(QMLA[m * 768 + h * 96 + 64 + i]), x2 = bf2f(QMLA[m * 768 + h * 96 + 80 + i]);
            const float* t = (const float*)(ws + WS_RMLA) + (m * 16 + i) * 2; q[64 + i] = x1 * t[0] - x2 * t[1]; q[80 + i] = x2 * t[0] + x1 * t[1]; }
    } else if constexpr (MODE == 1) {
#pragma unroll
        for (int d = 0; d < 64; ++d) q[d] = bf2f(PROJ[m * LDP + PC_QS + h * 64 + d]);
    } else {
#pragma unroll
        for (int d = 0; d < 128; ++d) q[d] = bf2f(PROJ[m * LDP + PC_QX + h * 128 + d]);
    }
    float o[DV];
#pragma unroll
    for (int d = 0; d < DV; ++d) o[d] = 0.f;
    float mx = -1e30f, l = 0.f;
    const int kbeg = MODE == 0 ? 0 : (MODE == 1 ? (q0 >= 128 ? q0 - 128 : 0) : 0), kend = MODE == 2 ? MEML : q0 + 128;
    for (int kt = kbeg; kt < kend; kt += 32) {
        __syncthreads();
        for (int idx = tid; idx < 32 * DQK; idx += 128) { const int j = idx / DQK, d = idx % DQK; float v;
            if constexpr (MODE == 0) { const size_t kr = (size_t)b * SEQ + kt + j; v = d < 64 ? bf2f(KVMLA[kr * 1024 + h * 128 + d]) : bf2f(PROJ[kr * LDP + PC_KR + (d - 64)]); }
            else if constexpr (MODE == 1) { const size_t kr = (size_t)b * SEQ + kt + j; v = bf2f(PROJ[kr * LDP + PC_KS + (h >> 2) * 64 + d]); }
            else { const size_t kr = (size_t)b * MEML + kt + j; v = bf2f(KVMEM[kr * 1024 + h * 128 + d]); }
            Ks[idx] = v; }
        for (int idx = tid; idx < 32 * DV; idx += 128) { const int j = idx / DV, d = idx % DV; float v;
            if constexpr (MODE == 0) { const size_t kr = (size_t)b * SEQ + kt + j; v = bf2f(KVMLA[kr * 1024 + h * 128 + 64 + d]); }
            else if constexpr (MODE == 1) { const size_t kr = (size_t)b * SEQ + kt + j; v = bf2f(PROJ[kr * LDP + PC_VS + (h >> 2) * 64 + d]); }
            else { const size_t kr = (size_t)b * MEML + kt + j; v = bf2f(KVMEM[kr * 1024 + 512 + h * 128 + vh * 64 + d]); }
            Vs[idx] = v; }
        __syncthreads();
        for (int j = 0; j < 32; ++j) {
            const int key = kt + j;
            bool ok = true; if (MODE == 0) ok = key <= qi; if (MODE == 1) ok = key <= qi && key >= qi - 127;
            if (!ok) continue;
            float s = 0.f;
#pragma unroll
            for (int d = 0; d < DQK; ++d) s += q[d] * Ks[j * DQK + d];
            if (s > mx) { const float al = exp2f(mx - s); l *= al;
#pragma unroll
                for (int d = 0; d < DV; ++d) o[d] *= al;
                mx = s; }
            const float p = exp2f(s - mx); l += p;
#pragma unroll
            for (int d = 0; d < DV; ++d) o[d] += p * Vs[j * DV + d];
        }
    }
    if constexpr (MODE == 1) { const float sl = a.sinks[h] * LOG2E; if (sl > mx) { const float al = exp2f(mx - sl); l *= al;
#pragma unroll
            for (int d = 0; d < DV; ++d) o[d] *= al;
            mx = sl; }
        l += exp2f(sl - mx); }
    const float rl = 1.f / l;
    bf16* O = (bf16*)(ws + WS_ATT) + m * 1536 + (MODE == 0 ? h * 64 : (MODE == 1 ? 512 + h * 64 : 1024 + h * 128 + vh * 64));
#pragma unroll
    for (int d = 0; d < DV; ++d) O[d] = (bf16)f2bf(o[d] * rl);
}

static void launch_fwd(const Args& base, int lo, int hi, int grid, hipStream_t stream) {
    Args a = base; a.ph_lo = lo; a.ph_hi = hi;
    hipLaunchKernelGGL(fwd, dim3(grid), dim3(NWAVES * 64), LDS_BYTES, stream, a);
}
extern "C" void kernel_launch(void* const* d_in, const int* in_sizes, int n_in, void* d_out, int out_size, void* d_ws, size_t ws_size, hipStream_t stream) {
    static int grid = 0;
    if (grid == 0) {
        if (n_in != 25 || in_sizes[0] != M * D || out_size != M * D || ws_size < WS_END) { fprintf(stderr, "kernel_launch: unexpected shapes (n_in %d, ws %zu)\n", n_in, ws_size); grid = -1; return; }
        int dev = 0, cus = 0;
        if (hipGetDevice(&dev) != hipSuccess || hipDeviceGetAttribute(&cus, hipDeviceAttributeMultiprocessorCount, dev) != hipSuccess) { grid = -1; return; }
        if (hipFuncSetAttribute((const void*)fwd, hipFuncAttributeMaxDynamicSharedMemorySize, LDS_BYTES) != hipSuccess) { fprintf(stderr, "kernel_launch: hipFuncSetAttribute failed\n"); grid = -1; return; }
        int per_cu = 0;
        if (hipOccupancyMaxActiveBlocksPerMultiprocessor(&per_cu, (const void*)fwd, NWAVES * 64, LDS_BYTES) != hipSuccess || per_cu < 1) fprintf(stderr, "kernel_launch: occupancy query says %d\n", per_cu);
        (void)hipGetLastError();
        grid = cus;
    }
    if (grid < 0) return;
    (void)hipMemsetAsync((char*)d_ws + WS_CTL, 0, CTL_ZERO_BYTES, stream);
    Args a{};
    a.x = (const float*)d_in[0]; a.mem = (const float*)d_in[1]; a.pos = (const int*)d_in[2];
    a.g_mix = (const float*)d_in[3]; a.w_in = (const float*)d_in[4]; a.g_mla_q = (const float*)d_in[5]; a.w_uq = (const float*)d_in[6]; a.g_mla_kv = (const float*)d_in[7];
    a.w_ukv = (const float*)d_in[8]; a.w_mla_o = (const float*)d_in[9]; a.sinks = (const float*)d_in[10]; a.w_swa_o = (const float*)d_in[11]; a.g_mem = (const float*)d_in[12];
    a.w_mem_kv = (const float*)d_in[13]; a.w_xa_o = (const float*)d_in[14]; a.b_gate = (const float*)d_in[15]; a.w_out = (const float*)d_in[16]; a.g_ffn = (const float*)d_in[17];
    a.w_router = (const float*)d_in[18]; a.b_router = (const float*)d_in[19]; a.w_gu = (const float*)d_in[20]; a.b_gu = (const float*)d_in[21]; a.w_dn = (const float*)d_in[22];
    a.b_dn = (const float*)d_in[23]; a.g_final = (const float*)d_in[24];
    a.out = (float*)d_out; a.ws = (unsigned char*)d_ws;
    constexpr unsigned INK = FAST_MASK | 0x985u;
    int p = 0;
    while (p < 12) {
        if (INK & (1u << p)) {
            int q = p + 1;
            if (ONE_LAUNCH) while (q < 12 && (INK & (1u << q))) ++q;
            launch_fwd(a, p, q, grid, stream); p = q; continue;
        }
        switch (p) {
            case 1: hipLaunchKernelGGL(nv_gemm<NV_PROJ>, dim3(75, M / 64), dim3(256), 0, stream, a);
                    hipLaunchKernelGGL(nv_gemm<NV_KVMEM>, dim3(16, MROWS / 64), dim3(256), 0, stream, a); break;
            case 3: hipLaunchKernelGGL(nv_gemm<NV_QMLA>, dim3(12, M / 64), dim3(256), 0, stream, a);
                    hipLaunchKernelGGL(nv_gemm<NV_KVMLA>, dim3(16, M / 64), dim3(256), 0, stream, a); break;
            case 4: hipLaunchKernelGGL(nv_attn<0>, dim3(SEQ / 128, 8, BATCH), dim3(128), 0, stream, a);
                    hipLaunchKernelGGL(nv_attn<1>, dim3(SEQ / 128, 8, BATCH), dim3(128), 0, stream, a);
                    hipLaunchKernelGGL(nv_attn<2>, dim3(SEQ / 128, 8, BATCH), dim3(128), 0, stream, a); break;
            case 5: hipLaunchKernelGGL(nv_gemm<NV_OUT3>, dim3(16, M / 64), dim3(256), 0, stream, a); break;
            case 6: hipLaunchKernelGGL(nv_gemm<NV_WOUT>, dim3(16, M / 64), dim3(256), 0, stream, a); break;
            case 9: hipLaunchKernelGGL(nv_gemm<NV_GU>, dim3(16, RMAX / 64), dim3(256), 0, stream, a); break;
            case 10: hipLaunchKernelGGL(nv_gemm<NV_DN>, dim3(16, RMAX / 64), dim3(256), 0, stream, a); break;
            default: break;
        }
        ++p;
    }
}
```

```cpp
#include <hip/hip_runtime.h>
#include <cstdio>
#include <cstdint>

#ifndef FAST_MASK
#define FAST_MASK 0x67Au
#endif
#ifndef ONE_LAUNCH
#define ONE_LAUNCH 1
#endif

#define GAS __attribute__((address_space(1)))
#define LAS __attribute__((address_space(3)))
typedef unsigned short bf16;
typedef unsigned v4u __attribute__((ext_vector_type(4)));
typedef unsigned v2u __attribute__((ext_vector_type(2)));
typedef float f32x4 __attribute__((ext_vector_type(4)));
typedef short bf16x8 __attribute__((ext_vector_type(8)));
typedef GAS unsigned gu32;

constexpr int BATCH = 2, SEQ = 8192, M = BATCH * SEQ, D = 1024, MEML = 256, MROWS = BATCH * MEML;
constexpr int NPSRC = 4768;
constexpr int LDP = 4864;
constexpr int PC_CQ = 0, PC_CKV = 256, PC_KR = 384, PC_QS = 512, PC_KS = 1024, PC_VS = 1152, PC_QX = 1280, PC_G = 1792;
constexpr int SC_QX = 1184, SC_G = 1696;
constexpr int NE = 32, TOPK = 4, DE = 1024;
constexpr int RMAX = 73728;
constexpr int NCHUNK = M / 64;
constexpr float EPS = 1e-6f;
constexpr float LOG2E = 1.4426950408889634f;
constexpr float C_MLA = LOG2E * 0.10206207261596577f;
constexpr float C_SWA = LOG2E * 0.125f;
constexpr float C_XA = LOG2E * 0.08838834764831845f;

constexpr size_t MiB = 1u << 20;
constexpr size_t WS_CTL = 0, CTL_ZERO_BYTES = 1 * MiB;
constexpr size_t WS_WIN = 2 * MiB;
constexpr size_t WS_WUQ = 12 * MiB;
constexpr size_t WS_WUKV = 12 * MiB + 512 * 1024;
constexpr size_t WS_WMKV = 13 * MiB;
constexpr size_t WS_WO3 = 15 * MiB;
constexpr size_t WS_WOUT = 18 * MiB;
constexpr size_t WS_RMLA = 20 * MiB;
constexpr size_t WS_RSWA = 22 * MiB;
constexpr size_t WS_MEMN = 26 * MiB;
constexpr size_t WS_KVMEM = 27 * MiB;
constexpr size_t WS_TKE = 28 * MiB;
constexpr size_t WS_TKW = 28 * MiB + 256 * 1024;
constexpr size_t WS_TKR = 28 * MiB + 512 * 1024;
constexpr size_t WS_LRK = 28 * MiB + 768 * 1024;
constexpr size_t WS_ROWW = 29 * MiB;
constexpr size_t WS_CNT = 30 * MiB;
constexpr size_t WS_TILE = 30 * MiB + 64 * 1024;
constexpr size_t WS_WGU = 32 * MiB;
constexpr size_t WS_WDN = 160 * MiB;
constexpr size_t WS_XN = 224 * MiB;
constexpr size_t WS_H = 256 * MiB;
constexpr size_t WS_PROJ = 320 * MiB;
constexpr size_t WS_QMLA = 472 * MiB;
constexpr size_t WS_KVMLA = 496 * MiB;
constexpr size_t WS_ATT = 528 * MiB;
constexpr size_t WS_MERGED = 576 * MiB;
constexpr size_t WS_MERGEDB = 640 * MiB;
constexpr size_t WS_HDN = 472 * MiB;
constexpr size_t WS_END = 672 * MiB;
constexpr int CW_TMO = 0, CW_CODE = 1, CW_BAR = 4096;

constexpr int RING_BYTES = 131072;
constexpr int LDSCTL_OFF = RING_BYTES, MISC_OFF = LDSCTL_OFF + 320;
constexpr int SMALL_OFF = LDSCTL_OFF + 1024;
constexpr int LDS_BYTES = 147456;
constexpr int NWAVES = 8;

struct Args {
    const float *x, *mem; const int* pos;
    const float *g_mix, *w_in, *g_mla_q, *w_uq, *g_mla_kv, *w_ukv, *w_mla_o, *sinks, *w_swa_o, *g_mem, *w_mem_kv, *w_xa_o, *b_gate, *w_out, *g_ffn,
        *w_router, *b_router, *w_gu, *b_gu, *w_dn, *b_dn, *g_final;
    float* out; unsigned char* ws; int ph_lo, ph_hi;
};

#define RLX_AGENT __ATOMIC_RELAXED, __HIP_MEMORY_SCOPE_AGENT
#define LDS_WAIT() asm volatile("s_waitcnt lgkmcnt(0)" ::: "memory")
#define VM_WAIT() asm volatile("s_waitcnt vmcnt(0)" ::: "memory")
__device__ __forceinline__ unsigned f2bf(float f) { unsigned u = __builtin_bit_cast(unsigned, f); return (u + 0x7fffu + ((u >> 16) & 1u)) >> 16; }
__device__ __forceinline__ unsigned pk2(float lo, float hi) { return f2bf(lo) | (f2bf(hi) << 16); }
__device__ __forceinline__ float bf2f(unsigned v) { return __builtin_bit_cast(float, v << 16); }
__device__ __forceinline__ float bflo(unsigned w) { return __builtin_bit_cast(float, w << 16); }
__device__ __forceinline__ float bfhi(unsigned w) { return __builtin_bit_cast(float, w & 0xffff0000u); }
__device__ __forceinline__ float wave_sum(float v) {
#pragma unroll
    for (int o = 1; o < 64; o <<= 1) v += __shfl_xor(v, o);
    return v;
}

#define XB_TMO      128
#define XB_XCNT(j)  (256  + 64 * (j))
#define XB_XSUB(j)  (1280 + 64 * (j))
#define XB_XGEN(j)  (2304 + 64 * (j))
#define XB_TOP      3328
#define XB_TOPGEN   3392
#define XCD_BAR_WORDS 3456
#define XB_SPIN_CAP (1u << 18)
__device__ __forceinline__ unsigned xb_ld(unsigned* p)              { return __hip_atomic_load(p, __ATOMIC_RELAXED, __HIP_MEMORY_SCOPE_AGENT); }
__device__ __forceinline__ unsigned xb_add(unsigned* p, unsigned v) { return __hip_atomic_fetch_add(p, v, __ATOMIC_RELAXED, __HIP_MEMORY_SCOPE_AGENT); }
__device__ __forceinline__ unsigned xb_xcc_id() { return (unsigned)__builtin_amdgcn_s_getreg((3 << 11) | 20) & 0xFu; }
#define XB_SPIN(cond, bar) do { unsigned _sp = 0; while (cond) { __builtin_amdgcn_s_sleep(1); \
    if ((++_sp & 255u) == 0u) { if (xb_ld(&(bar)[XB_TMO])) break; if (_sp > XB_SPIN_CAP) { atomicAdd(&(bar)[XB_TMO], 1u); break; } } } } while (0)
struct XcdBarrier { unsigned* bar; unsigned x; volatile LAS unsigned* st; };
__device__ __forceinline__ XcdBarrier xcd_barrier_post(unsigned* bar, volatile LAS unsigned* st) {
    XcdBarrier b; b.bar = bar; b.x = xb_xcc_id(); b.st = st;
    if (threadIdx.x == 0) (void)xb_add(&bar[XB_XCNT(b.x)], 1u);
    return b;
}
__device__ __forceinline__ void xcd_barrier_complete(unsigned* bar, unsigned x, unsigned& nloc, unsigned& nx) {
    const unsigned G = gridDim.x * gridDim.y * gridDim.z;
    unsigned sum, cnt, mine, sp = 0u;
    for (;;) {
        sum = 0u; cnt = 0u; mine = 0u;
#pragma unroll
        for (unsigned j = 0; j < 16; ++j) { const unsigned c = xb_ld(&bar[XB_XCNT(j)]); sum += c; cnt += (c > 0u) ? 1u : 0u; mine = (j == x) ? c : mine; }
        if (sum == G) break;
        __builtin_amdgcn_s_sleep(1);
        if ((++sp & 255u) == 0u) { if (xb_ld(&bar[XB_TMO])) break; if (sp > XB_SPIN_CAP) { atomicAdd(&bar[XB_TMO], 1u); break; } }
    }
    nloc = mine > 0u ? mine : 1u; nx = cnt > 0u ? cnt : 1u;
}
__device__ __forceinline__ void xcd_barrier(const XcdBarrier& b) {
    asm volatile("s_waitcnt vmcnt(0)" ::: "memory");
    __syncthreads();
    if (threadIdx.x == 0) {
        unsigned* bar = b.bar;
        __builtin_amdgcn_s_waitcnt(0);
        unsigned nloc = b.st[0], nx = b.st[1];
        if (nloc == 0u) { xcd_barrier_complete(bar, b.x, nloc, nx); b.st[0] = nloc; b.st[1] = nx; }
        const unsigned old = xb_add(&bar[XB_XSUB(b.x)], 1u);
        const unsigned gen = old / nloc;
        if (old + 1u == (gen + 1u) * nloc) {
            __builtin_amdgcn_fence(__ATOMIC_RELEASE, "agent");
            asm volatile("s_waitcnt vmcnt(0)" ::: "memory");
            const unsigned og = xb_add(&bar[XB_TOP], 1u);
            const unsigned tg = og / nx;
            if (og + 1u == (tg + 1u) * nx) xb_add(&bar[XB_TOPGEN], 1u);
            else XB_SPIN(xb_ld(&bar[XB_TOPGEN]) == tg, bar);
            __builtin_amdgcn_fence(__ATOMIC_ACQUIRE, "agent");
            xb_add(&bar[XB_XGEN(b.x)], 1u);
            asm volatile("s_waitcnt vmcnt(0)" ::: "memory");
        } else {
            XB_SPIN(xb_ld(&bar[XB_XGEN(b.x)]) == gen, bar);
            __builtin_amdgcn_fence(__ATOMIC_ACQUIRE, "agent");
            asm volatile("s_waitcnt vmcnt(0)" ::: "memory");
        }
    }
    __syncthreads();
}

namespace pg8 {
#define PG8_LAS __attribute__((address_space(3)))
typedef unsigned short bf16_t;
typedef short bf16x8 __attribute__((ext_vector_type(8)));
typedef float f32x4 __attribute__((ext_vector_type(4)));
typedef unsigned u32x4 __attribute__((ext_vector_type(4)));
constexpr int BM = 256, BK = 64, HALF = 128, HTB = HALF * BK * 2  , STAGE_BYTES = 8 * HTB, NXCD = 8, WGM = 8;

__host__ __device__ __forceinline__ int lds_byte(int r, int c) { const int st = (r >> 4) * 2 + (c >> 5), rr = r & 15, cc = c & 31, ob = rr * 64 + cc * 2; return st * 1024 + (ob ^ (((ob >> 9) & 1) << 5)); }
__host__ __device__ __forceinline__ void stage_rc(int b, int& R, int& C) { const int st = b / 1024, sb = b % 1024, swz = sb ^ (((sb >> 9) & 1) << 5); R = (st >> 1) * 16 + swz / 64; C = (st & 1) * 32 + (swz % 64) / 2; }
__host__ __device__ __forceinline__ int perm32(int rho) { const int n = rho >> 4, i = rho & 15; return 8 * (i >> 2) + 4 * n + (i & 3); }

struct Unit { int pm, pn, ka; };
struct Gemm { const bf16_t* A; const bf16_t* Bt; int M, N, K, lda, ldb; };

__device__ __forceinline__ unsigned cvt_pk_bf16(float lo, float hi) { unsigned r; asm volatile("v_cvt_pk_bf16_f32 %0, %1, %2" : "=v"(r) : "v"(lo), "v"(hi)); return r; }
typedef float f32x2 __attribute__((ext_vector_type(2)));
template <class Epi, class Sched, bool ALIGN_EPI = false, bool SP2 = false>
__device__ __forceinline__ void gemm_phase(PG8_LAS unsigned char* lds, const Gemm g, const Sched& S, const Epi& E) {
    const int tid = threadIdx.x, wid = __builtin_amdgcn_readfirstlane(tid >> 6), lane = tid & 63, wr = wid >> 2, wc = wid & 3, fr = lane & 15, fq = lane >> 4;
    const int K = g.K, nt = K / BK;
    unsigned voffA[2], voffB[2];
#pragma unroll
    for (int i = 0; i < 2; ++i) { int R, C; stage_rc(tid * 16 + i * 8192, R, C); const int Rb = Epi::PERM ? ((R & ~31) + perm32(R & 31)) : R;
        voffA[i] = (unsigned)(R * g.lda + C) * 2u; voffB[i] = (unsigned)(Rb * g.ldb + C) * 2u; }
    const size_t kstep = (size_t)(BK * 2);
    const size_t hstepA = (size_t)HALF * g.lda * 2, hstepB = (size_t)HALF * g.ldb * 2;
    const size_t tstepA = 2 * hstepA, tstepB = 2 * hstepB;
    const unsigned ldsw = (unsigned)wid * 1024u;
    const int aoff = lds_byte(wr * 64 + fr, fq * 8), boff = lds_byte(wc * 32 + fr, fq * 8);
#define PG8_SA(b, h) (((b) * 2 + (h)) * HTB)
#define PG8_SB(b, h) ((4 + (b) * 2 + (h)) * HTB)
#define PG8_STAGE(bufoff, gbase, voff) do { _Pragma("unroll") for (int _i = 0; _i < 2; ++_i) \
        __builtin_amdgcn_global_load_lds((const unsigned*)((const char*)(gbase) + (voff)[_i]), (PG8_LAS unsigned*)(lds + (bufoff) + ldsw + _i * 8192), 16, 0, 0); } while (0)
#define PG8_LDA(dst, b, h) do { _Pragma("unroll") for (int m = 0; m < 4; ++m) _Pragma("unroll") for (int k = 0; k < 2; ++k) dst[m][k] = *(const PG8_LAS bf16x8*)(lds + PG8_SA(b, h) + aoff + m * 2048 + k * 1024); } while (0)
#define PG8_LDB(dst, b, h) do { _Pragma("unroll") for (int n = 0; n < 2; ++n) _Pragma("unroll") for (int k = 0; k < 2; ++k) dst[n][k] = *(const PG8_LAS bf16x8*)(lds + PG8_SB(b, h) + boff + n * 2048 + k * 1024); } while (0)
#define PG8_MMA(ai, bj, At, Bt) do { __builtin_amdgcn_s_setprio(1); _Pragma("unroll") for (int m = 0; m < 4; ++m) _Pragma("unroll") for (int n = 0; n < 2; ++n) _Pragma("unroll") for (int k = 0; k < 2; ++k) \
        acc[ai][bj][m][n] = __builtin_amdgcn_mfma_f32_16x16x32_bf16(Bt[n][k], At[m][k], acc[ai][bj][m][n], 0, 0, 0); __builtin_amdgcn_s_setprio(0); } while (0)
#define PG8_WAIT_V(n) asm volatile("s_waitcnt vmcnt(" #n ")" ::: "memory")
#define PG8_WAIT_L(n) asm volatile("s_waitcnt lgkmcnt(" #n ")" ::: "memory")
#define PG8_BAR __builtin_amdgcn_s_barrier()
#define PG8_SCHED __builtin_amdgcn_sched_barrier(0)
    Unit cur, nxt; int ui = 0;
    if (!S.next(0, cur)) return;
    f32x4 acc[2][2][4][2];
#pragma unroll
    for (int a = 0; a < 2; ++a)
#pragma unroll
        for (int b = 0; b < 2; ++b)
#pragma unroll
            for (int m = 0; m < 4; ++m)
#pragma unroll
                for (int n = 0; n < 2; ++n) acc[a][b][m][n] = (f32x4){0.f, 0.f, 0.f, 0.f};
    bf16x8 At[4][2], B0[2][2], B1[2][2];
    const char* cA = (const char*)g.A + (size_t)cur.pm * tstepA + (size_t)cur.ka * 2; const char* cB = (const char*)g.Bt + (size_t)cur.pn * tstepB;
    S.a_ready(cur);
    if constexpr (SP2) {
        PG8_STAGE(PG8_SB(0, 0), cB, voffB); PG8_STAGE(PG8_SB(0, 1), cB + hstepB, voffB); PG8_STAGE(PG8_SA(0, 0), cA, voffA); PG8_STAGE(PG8_SA(0, 1), cA + hstepA, voffA);
        if (wr == 1) PG8_BAR;
        PG8_WAIT_V(2); PG8_BAR;
        PG8_STAGE(PG8_SB(1, 0), cB + kstep, voffB); PG8_STAGE(PG8_SA(1, 0), cA + kstep, voffA); PG8_STAGE(PG8_SB(1, 1), cB + hstepB + kstep, voffB);
        PG8_WAIT_V(6); PG8_BAR;
    } else {
        PG8_STAGE(PG8_SB(0, 0), cB, voffB); PG8_STAGE(PG8_SA(0, 0), cA, voffA); PG8_STAGE(PG8_SB(0, 1), cB + hstepB, voffB); PG8_STAGE(PG8_SA(0, 1), cA + hstepA, voffA);
        if (wr == 1) PG8_BAR;
        PG8_WAIT_V(4); PG8_BAR;
        PG8_STAGE(PG8_SB(1, 0), cB + kstep, voffB); PG8_STAGE(PG8_SA(1, 0), cA + kstep, voffA); PG8_STAGE(PG8_SB(1, 1), cB + hstepB + kstep, voffB);
        PG8_WAIT_V(6); PG8_BAR;
    }
    for (;;) {
        const bool has_next = S.next(ui + 1, nxt);
        const char* nA = has_next ? (const char*)g.A + (size_t)nxt.pm * tstepA + (size_t)nxt.ka * 2 : cA; const char* nB = has_next ? (const char*)g.Bt + (size_t)nxt.pn * tstepB : cB;
        for (int t = 0; t < nt; t += 2) {
            const bool last = (t == nt - 2);
            const char* a1 = cA + (size_t)(t + 1) * kstep;
            const char* a2 = last ? nA : cA + (size_t)(t + 2) * kstep; const char* b2 = last ? nB : cB + (size_t)(t + 2) * kstep;
            const char* a3 = a2 + kstep; const char* b3 = b2 + kstep;
            if (last && has_next) S.a_ready(nxt);
            if constexpr (SP2) {
            PG8_LDB(B0, 0, 0); PG8_LDB(B1, 0, 1); PG8_SCHED; PG8_LDA(At, 0, 0); PG8_STAGE(PG8_SA(1, 1), a1 + hstepA, voffA);
            PG8_WAIT_V(8); PG8_WAIT_L(0); PG8_BAR; PG8_MMA(0, 0, At, B0); PG8_MMA(0, 1, At, B1); PG8_BAR; PG8_SCHED;
            PG8_LDA(At, 0, 1); PG8_STAGE(PG8_SB(0, 0), b2, voffB); PG8_STAGE(PG8_SB(0, 1), b2 + hstepB, voffB); PG8_STAGE(PG8_SA(0, 0), a2, voffA);
            PG8_WAIT_V(8); PG8_WAIT_L(0); PG8_BAR; PG8_MMA(1, 0, At, B0); PG8_MMA(1, 1, At, B1); PG8_BAR; PG8_SCHED;
            PG8_LDB(B0, 1, 0); PG8_LDB(B1, 1, 1); PG8_SCHED; PG8_LDA(At, 1, 0); PG8_STAGE(PG8_SA(0, 1), a2 + hstepA, voffA);
            PG8_WAIT_V(8); PG8_WAIT_L(0); PG8_BAR; PG8_MMA(0, 0, At, B0); PG8_MMA(0, 1, At, B1); PG8_BAR; PG8_SCHED;
            PG8_LDA(At, 1, 1); PG8_STAGE(PG8_SB(1, 0), b3, voffB); PG8_STAGE(PG8_SB(1, 1), b3 + hstepB, voffB); PG8_STAGE(PG8_SA(1, 0), a3, voffA);
            PG8_WAIT_V(8); PG8_WAIT_L(0); PG8_BAR; PG8_MMA(1, 0, At, B0); PG8_MMA(1, 1, At, B1); PG8_BAR; PG8_SCHED;
            } else {
            PG8_LDB(B0, 0, 0); PG8_SCHED; PG8_LDA(At, 0, 0); PG8_STAGE(PG8_SA(1, 1), a1 + hstepA, voffA);
            PG8_WAIT_L(8); PG8_BAR; PG8_WAIT_L(0); PG8_MMA(0, 0, At, B0); PG8_BAR; PG8_SCHED;
            PG8_LDB(B1, 0, 1); PG8_STAGE(PG8_SB(0, 0), b2, voffB);
            PG8_BAR; PG8_WAIT_L(0); PG8_MMA(0, 1, At, B1); PG8_BAR;
            PG8_LDA(At, 0, 1); PG8_STAGE(PG8_SA(0, 0), a2, voffA);
            PG8_BAR; PG8_WAIT_L(0); PG8_MMA(1, 0, At, B0); PG8_BAR; PG8_SCHED;
            PG8_STAGE(PG8_SB(0, 1), b2 + hstepB, voffB);
            PG8_WAIT_V(6); PG8_BAR; PG8_MMA(1, 1, At, B1); PG8_BAR;
            PG8_LDB(B0, 1, 0); PG8_SCHED; PG8_LDA(At, 1, 0); PG8_STAGE(PG8_SA(0, 1), a2 + hstepA, voffA);
            PG8_WAIT_L(8); PG8_BAR; PG8_WAIT_L(0); PG8_MMA(0, 0, At, B0); PG8_BAR; PG8_SCHED;
            PG8_LDB(B1, 1, 1); PG8_STAGE(PG8_SB(1, 0), b3, voffB);
            PG8_BAR; PG8_WAIT_L(0); PG8_MMA(0, 1, At, B1); PG8_BAR;
            PG8_LDA(At, 1, 1); PG8_STAGE(PG8_SA(1, 0), a3, voffA);
            PG8_BAR; PG8_WAIT_L(0); PG8_MMA(1, 0, At, B0); PG8_BAR; PG8_SCHED;
            PG8_STAGE(PG8_SB(1, 1), b3 + hstepB, voffB);
            PG8_WAIT_V(6); PG8_BAR; PG8_MMA(1, 1, At, B1); PG8_BAR;
            }
        }
        if constexpr (ALIGN_EPI) { if (wr == 0) PG8_BAR; }
        if constexpr (!Epi::AFTER_DRAIN) { E(acc, cur, wr, wc, fr, fq); S.done(cur); }
        if (!has_next) break;
#pragma unroll
        for (int a = 0; a < 2; ++a)
#pragma unroll
            for (int b = 0; b < 2; ++b)
#pragma unroll
                for (int m = 0; m < 4; ++m)
#pragma unroll
                    for (int n = 0; n < 2; ++n) acc[a][b][m][n] = (f32x4){0.f, 0.f, 0.f, 0.f};
        cur = nxt; cA = nA; cB = nB; ++ui;
        if constexpr (ALIGN_EPI) { if (wr == 1) PG8_BAR; }
    }
    PG8_WAIT_V(0);
    if constexpr (!ALIGN_EPI) { if (wr == 0) PG8_BAR; }
    PG8_BAR;
    if constexpr (Epi::AFTER_DRAIN) { E.fused(acc, cur, wr, wc, fr, fq, lds, wid, lane); S.done(cur); }
#undef PG8_SA
#undef PG8_SB
#undef PG8_STAGE
#undef PG8_LDA
#undef PG8_LDB
#undef PG8_MMA
#undef PG8_WAIT_V
#undef PG8_WAIT_L
#undef PG8_BAR
#undef PG8_SCHED
}
struct StaticOrder {
    int nM, nN, nwg, G, c;
    __host__ __device__ void init(int M, int N, int G_, int c_) { nM = M / BM; nN = N / BM; nwg = nM * nN; G = G_; c = c_; }
    __host__ __device__ bool next(int i, Unit& u) const {
        const long L = (long)i * G + c; if (L >= nwg) return false;
        int wgid = (int)L; { const int q = nwg / NXCD, r = nwg % NXCD, xcd = wgid % NXCD, off = wgid / NXCD; wgid = (xcd < r ? xcd * (q + 1) : r * (q + 1) + (xcd - r) * q) + off; }
        const int nig = WGM * nN, gid = wgid / nig, fm = gid * WGM, gsz = (nM - fm) < WGM ? (nM - fm) : WGM;
        u.pm = fm + ((wgid % nig) % gsz); u.pn = (wgid % nig) / gsz; u.ka = 0; return true;
    }
    __device__ __forceinline__ void a_ready(const Unit&) const {}
    __device__ __forceinline__ void done(const Unit&) const {}
};
struct SimpleOrder {
    int nN, nwg, G, c;
    __device__ __forceinline__ bool next(int i, Unit& u) const { const int L = i * G + c; if (L >= nwg) return false; u.pm = L / nN; u.pn = L % nN; u.ka = 0; return true; }
    __device__ __forceinline__ void a_ready(const Unit&) const {}
    __device__ __forceinline__ void done(const Unit&) const {}
};
struct TailOrder {
    int nN, nwg, G, c;
    __device__ __forceinline__ bool next(int i, Unit& u) const { const int L = c - (G - nwg); if (i > 0 || L < 0 || L >= nwg) return false; u.pm = L / nN; u.pn = L % nN; u.ka = 0; return true; }
    __device__ __forceinline__ void a_ready(const Unit&) const {}
    __device__ __forceinline__ void done(const Unit&) const {}
};
struct Gate3Order {
    int G, c;
    __device__ __forceinline__ bool next(int i, Unit& u) const { const int t = (i / 3) * G + c, b = i % 3; if (t >= 256) return false; u.pm = t >> 2; u.pn = b * 4 + (t & 3); u.ka = b * 512; return true; }
    __device__ __forceinline__ void a_ready(const Unit&) const {}
    __device__ __forceinline__ void done(const Unit&) const {}
};
template <int NPN> struct MoeOrder {
    const int* tile; int G, c;
    __device__ __forceinline__ bool next(int i, Unit& u) const { const int nt = __builtin_amdgcn_readfirstlane(tile[0]); const int L = i * G + c; if (L >= nt * NPN) return false;
        u.pm = L / NPN; const int e = __builtin_amdgcn_readfirstlane(tile[64 + u.pm]); u.pn = e * NPN + (L % NPN); u.ka = 0; return true; }
    __device__ __forceinline__ void a_ready(const Unit&) const {}
    __device__ __forceinline__ void done(const Unit&) const {}
};
__device__ __forceinline__ u32x4 pack8(const f32x4 v0, const f32x4 v1) { u32x4 w; w.x = cvt_pk_bf16(v0[0], v0[1]); w.y = cvt_pk_bf16(v0[2], v0[3]); w.z = cvt_pk_bf16(v1[0], v1[1]); w.w = cvt_pk_bf16(v1[2], v1[3]); return w; }
__device__ __forceinline__ float sigm(float x) { return __builtin_amdgcn_rcpf(1.f + __expf(-x)); }
struct EpiPlain {
    static constexpr bool PERM = true, AFTER_DRAIN = false;
    bf16_t* O; int ldc; float scale;
    __device__ __forceinline__ void operator()(const f32x4 (&acc)[2][2][4][2], const Unit& u, int wr, int wc, int fr, int fq) const {
        const int row0 = u.pm * BM + wr * 64 + fr, col0 = u.pn * BM + wc * 32 + 8 * fq;
#pragma unroll
        for (int ai = 0; ai < 2; ++ai)
#pragma unroll
            for (int m = 0; m < 4; ++m) { bf16_t* rowp = O + (size_t)(row0 + ai * HALF + m * 16) * ldc + col0;
#pragma unroll
                for (int bj = 0; bj < 2; ++bj) *(u32x4*)(rowp + bj * HALF) = pack8(acc[ai][bj][m][0] * scale, acc[ai][bj][m][1] * scale); }
    }
};
struct EpiProj {
    static constexpr bool PERM = true, AFTER_DRAIN = false;
    bf16_t* O; const float* bgate; float cxa;
    __device__ __forceinline__ void operator()(const f32x4 (&acc)[2][2][4][2], const Unit& u, int wr, int wc, int fr, int fq) const {
        const int row0 = u.pm * BM + wr * 64 + fr, col0 = u.pn * BM + wc * 32 + 8 * fq;
        const bool gate = u.pn >= 7; const float sc = (u.pn == 5 || u.pn == 6) ? cxa : 1.f;
        f32x4 bv[2][2];
#pragma unroll
        for (int bj = 0; bj < 2; ++bj)
#pragma unroll
            for (int n = 0; n < 2; ++n) bv[bj][n] = gate ? *(const f32x4*)(bgate + (col0 - 1792) + bj * HALF + 4 * n) : (f32x4){0.f, 0.f, 0.f, 0.f};
#pragma unroll
        for (int ai = 0; ai < 2; ++ai)
#pragma unroll
            for (int m = 0; m < 4; ++m) { bf16_t* rowp = O + (size_t)(row0 + ai * HALF + m * 16) * 4864 + col0;
#pragma unroll
                for (int bj = 0; bj < 2; ++bj) { f32x4 v0 = acc[ai][bj][m][0], v1 = acc[ai][bj][m][1];
                    if (gate) { v0 += bv[bj][0]; v1 += bv[bj][1];
#pragma unroll
                        for (int q = 0; q < 4; ++q) { v0[q] = sigm(v0[q]); v1[q] = sigm(v1[q]); } }
                    else { v0 = v0 * sc; v1 = v1 * sc; }
                    *(u32x4*)(rowp + bj * HALF) = pack8(v0, v1); } }
    }
};
struct EpiGate3 {
    static constexpr bool PERM = true, AFTER_DRAIN = false;
    const bf16_t* P; float* Mg; bf16_t* Mb;
    __device__ __forceinline__ void operator()(const f32x4 (&acc)[2][2][4][2], const Unit& u, int wr, int wc, int fr, int fq) const {
        const int b = u.pn >> 2, row0 = u.pm * BM + wr * 64 + fr, col0 = (u.pn & 3) * BM + wc * 32 + 8 * fq;
#pragma unroll
        for (int ai = 0; ai < 2; ++ai)
#pragma unroll
            for (int m = 0; m < 4; ++m) { const size_t row = (size_t)(row0 + ai * HALF + m * 16);
#pragma unroll
                for (int bj = 0; bj < 2; ++bj) { const int col = col0 + bj * HALF;
                    const u32x4 gw = *(const u32x4*)(P + row * 4864 + 1792 + b * 1024 + col);
                    f32x4 g0, g1; g0[0] = __builtin_bit_cast(float, gw.x << 16); g0[1] = __builtin_bit_cast(float, gw.x & 0xffff0000u); g0[2] = __builtin_bit_cast(float, gw.y << 16); g0[3] = __builtin_bit_cast(float, gw.y & 0xffff0000u);
                    g1[0] = __builtin_bit_cast(float, gw.z << 16); g1[1] = __builtin_bit_cast(float, gw.z & 0xffff0000u); g1[2] = __builtin_bit_cast(float, gw.w << 16); g1[3] = __builtin_bit_cast(float, gw.w & 0xffff0000u);
                    f32x4 v0 = acc[ai][bj][m][0] * g0, v1 = acc[ai][bj][m][1] * g1;
                    float* mp = Mg + row * 1024 + col;
                    if (b > 0) { v0 += *(const f32x4*)mp; v1 += *(const f32x4*)(mp + 4); }
                    if (b < 2) { *(f32x4*)mp = v0; *(f32x4*)(mp + 4) = v1; }
                    else *(u32x4*)(Mb + row * 1024 + col) = pack8(v0, v1); } }
    }
};
struct EpiResF32 {
    static constexpr bool PERM = true, AFTER_DRAIN = false;
    const float* base; float* O;
    __device__ __forceinline__ void operator()(const f32x4 (&acc)[2][2][4][2], const Unit& u, int wr, int wc, int fr, int fq) const {
        const int row0 = u.pm * BM + wr * 64 + fr, col0 = u.pn * BM + wc * 32 + 8 * fq;
#pragma unroll
        for (int ai = 0; ai < 2; ++ai)
#pragma unroll
            for (int m = 0; m < 4; ++m) { const size_t off = (size_t)(row0 + ai * HALF + m * 16) * 1024 + col0;
#pragma unroll
                for (int bj = 0; bj < 2; ++bj) { const float* bp = base + off + bj * HALF; float* op = O + off + bj * HALF;
                    *(f32x4*)op = *(const f32x4*)bp + acc[ai][bj][m][0]; *(f32x4*)(op + 4) = *(const f32x4*)(bp + 4) + acc[ai][bj][m][1]; } }
    }
};
struct EpiSwiglu {
    static constexpr bool PERM = true, AFTER_DRAIN = false;
    bf16_t* O; const float* bgu;
    __device__ __forceinline__ void operator()(const f32x4 (&acc)[2][2][4][2], const Unit& u, int wr, int wc, int fr, int fq) const {
        const int e = u.pn >> 3, row0 = u.pm * BM + wr * 64 + fr, col0 = (u.pn & 7) * HALF + wc * 32 + 8 * fq;
        const float* bp = bgu + (size_t)e * 2048 + col0;
        const f32x4 bg0 = *(const f32x4*)bp, bg1 = *(const f32x4*)(bp + 4), bl0 = *(const f32x4*)(bp + 1024), bl1 = *(const f32x4*)(bp + 1028);
#pragma unroll
        for (int ai = 0; ai < 2; ++ai)
#pragma unroll
            for (int m = 0; m < 4; ++m) { f32x4 g0 = acc[ai][0][m][0] + bg0, g1 = acc[ai][0][m][1] + bg1, l0 = acc[ai][1][m][0] + bl0, l1 = acc[ai][1][m][1] + bl1, h0, h1;
#pragma unroll
                for (int q = 0; q < 4; ++q) { float g = fminf(g0[q], 7.f), l = fminf(fmaxf(l0[q], -7.f), 7.f); h0[q] = g * sigm(1.702f * g) * (l + 1.f);
                    g = fminf(g1[q], 7.f); l = fminf(fmaxf(l1[q], -7.f), 7.f); h1[q] = g * sigm(1.702f * g) * (l + 1.f); }
                *(u32x4*)(O + (size_t)(row0 + ai * HALF + m * 16) * 1024 + col0) = pack8(h0, h1); }
    }
};
struct EpiDown {
    static constexpr bool PERM = true, AFTER_DRAIN = false;
    bf16_t* O; const float* bdn; const float* roww;
    __device__ __forceinline__ void operator()(const f32x4 (&acc)[2][2][4][2], const Unit& u, int wr, int wc, int fr, int fq) const {
        const int e = u.pn >> 2, row0 = u.pm * BM + wr * 64 + fr, col0 = (u.pn & 3) * BM + wc * 32 + 8 * fq;
        f32x4 bv[2][2];
#pragma unroll
        for (int bj = 0; bj < 2; ++bj)
#pragma unroll
            for (int n = 0; n < 2; ++n) bv[bj][n] = *(const f32x4*)(bdn + (size_t)e * 1024 + col0 + bj * HALF + 4 * n);
#pragma unroll
        for (int ai = 0; ai < 2; ++ai)
#pragma unroll
            for (int m = 0; m < 4; ++m) { const int row = row0 + ai * HALF + m * 16; const float w = roww[row]; bf16_t* rowp = O + (size_t)row * 1024 + col0;
#pragma unroll
                for (int bj = 0; bj < 2; ++bj) *(u32x4*)(rowp + bj * HALF) = pack8((acc[ai][bj][m][0] + bv[bj][0]) * w, (acc[ai][bj][m][1] + bv[bj][1]) * w); }
    }
};
}

struct Frame {
    LAS unsigned char* lds;
    volatile LAS unsigned* MISC;
    gu32* ctl;
    int tid, lane, wave, vcu, G;
    unsigned char* ws;
};
#define WSP(T, off) ((T*)(F.ws + (off)))

__device__ __forceinline__ void rms_row_to_bf16(const float* xrow, const float* g, bf16* orow, int lane) {
    const GAS f32x4* xr = (const GAS f32x4*)xrow + lane; const GAS f32x4* gr = (const GAS f32x4*)g + lane;
    f32x4 v[4]; float s = 0.f;
#pragma unroll
    for (int j = 0; j < 4; ++j) { v[j] = xr[64 * j]; s += (v[j].x * v[j].x + v[j].y * v[j].y) + (v[j].z * v[j].z + v[j].w * v[j].w); }
    const float rstd = 1.f / sqrtf(wave_sum(s) * (1.f / D) + EPS);
    GAS unsigned long long* o8 = (GAS unsigned long long*)orow + lane;
#pragma unroll
    for (int j = 0; j < 4; ++j) { const f32x4 gg = gr[64 * j];
        o8[64 * j] = (unsigned long long)pk2(v[j].x * rstd * gg.x, v[j].y * rstd * gg.y) | ((unsigned long long)pk2(v[j].z * rstd * gg.z, v[j].w * rstd * gg.w) << 32); }
}
__device__ __forceinline__ void p0_transpose_item(const float* W, int ldw, int src_n0, int k0, bf16* WT, int K, int dst_row0, LAS float* scr, int lane) {
#pragma unroll 8
    for (int i = 0; i < 32; ++i) { const int kk = 2 * i + (lane >> 5); scr[kk * 33 + (lane & 31)] = src_n0 >= 0 ? W[(size_t)(k0 + kk) * ldw + src_n0 + (lane & 31)] : 0.f; }
    LDS_WAIT(); asm volatile("" ::: "memory");
    const int c = lane & 7;
#pragma unroll
    for (int j = 0; j < 4; ++j) { const int n = (lane >> 3) + 8 * j; const LAS float* s = scr + (8 * c) * 33 + n;
        v4u o; o.x = pk2(s[0 * 33], s[1 * 33]); o.y = pk2(s[2 * 33], s[3 * 33]); o.z = pk2(s[4 * 33], s[5 * 33]); o.w = pk2(s[6 * 33], s[7 * 33]);
        *(GAS v4u*)(WT + (size_t)(dst_row0 + n) * K + k0 + 8 * c) = o; }
    LDS_WAIT(); asm volatile("" ::: "memory");
}
__device__ __forceinline__ void p0_prologue(Frame& F, const Args& a) {
    const int gw = F.vcu * NWAVES + F.wave, NGW = F.G * NWAVES;
    if (FAST_MASK != 0u) {
        LAS float* scr = (LAS float*)(F.lds + F.wave * 16384);
        constexpr int I_IN = 16 * 152, I_UQ = 4 * 24, I_UKV = 2 * 32, I_MKV = 16 * 32, I_O = 8 * 32, I_OUT = 16 * 32, I_GU = 16 * 64, I_DN = 16 * 32;
        constexpr int NITEMS = I_IN + I_UQ + I_UKV + I_MKV + 3 * I_O + I_OUT + NE * I_GU + NE * I_DN;
        for (int it = gw; it < NITEMS; it += NGW) {
            int r = it;
            if (r < I_IN) { const int kb = r / 152, nb = r % 152, n0 = nb * 32; const int src = n0 < 416 ? n0 : (n0 < 512 ? -1 : n0 - 96);
                p0_transpose_item(a.w_in, NPSRC, src, kb * 64, WSP(bf16, WS_WIN), 1024, n0, scr, F.lane); continue; } r -= I_IN;
            if (r < I_UQ) { const int kb = r / 24, nb = r % 24; p0_transpose_item(a.w_uq, 768, nb * 32, kb * 64, WSP(bf16, WS_WUQ), 256, nb * 32, scr, F.lane); continue; } r -= I_UQ;
            if (r < I_UKV) { const int kb = r / 32, nb = r % 32; p0_transpose_item(a.w_ukv, 1024, nb * 32, kb * 64, WSP(bf16, WS_WUKV), 128, nb * 32, scr, F.lane); continue; } r -= I_UKV;
            if (r < I_MKV) { const int kb = r / 32, nb = r % 32; p0_transpose_item(a.w_mem_kv, 1024, nb * 32, kb * 64, WSP(bf16, WS_WMKV), 1024, nb * 32, scr, F.lane); continue; } r -= I_MKV;
            if (r < 3 * I_O) { const int b = r / I_O, q = r % I_O, kb = q / 32, nb = q % 32; const float* w = b == 0 ? a.w_mla_o : (b == 1 ? a.w_swa_o : a.w_xa_o);
                p0_transpose_item(w, 1024, nb * 32, kb * 64, WSP(bf16, WS_WO3), 512, b * 1024 + nb * 32, scr, F.lane); continue; } r -= 3 * I_O;
            if (r < I_OUT) { const int kb = r / 32, nb = r % 32; p0_transpose_item(a.w_out, 1024, nb * 32, kb * 64, WSP(bf16, WS_WOUT), 1024, nb * 32, scr, F.lane); continue; } r -= I_OUT;
            if (r < NE * I_GU) { const int e = r / I_GU, q = r % I_GU, kb = q / 64, nb = q % 64, n0 = nb * 32, pn = n0 >> 8, j = n0 & 255;
                const int src = j < 128 ? 128 * pn + j : 1024 + 128 * pn + (j - 128);
                p0_transpose_item(a.w_gu + (size_t)e * 1024 * 2048, 2048, src, kb * 64, WSP(bf16, WS_WGU), 1024, e * 2048 + n0, scr, F.lane); continue; } r -= NE * I_GU;
            { const int e = r / I_DN, q = r % I_DN, kb = q / 32, nb = q % 32;
              p0_transpose_item(a.w_dn + (size_t)e * 1024 * 1024, 1024, nb * 32, kb * 64, WSP(bf16, WS_WDN), 1024, e * 1024 + nb * 32, scr, F.lane); }
        }
    }
    for (int m = gw; m < M; m += NGW) rms_row_to_bf16(a.x + (size_t)m * D, a.g_mix, WSP(bf16, WS_XN) + (size_t)m * D, F.lane);
    for (int m = gw; m < MROWS; m += NGW) rms_row_to_bf16(a.mem + (size_t)m * D, a.g_mem, WSP(bf16, WS_MEMN) + (size_t)m * D, F.lane);
    for (int m = gw; m < M; m += NGW) {
        if (F.lane < 48) {
            const bool mla = F.lane < 16; const int i = mla ? F.lane : F.lane - 16;
            const float inv = powf(10000.f, mla ? -(float)(2 * i) / 32.f : -(float)(2 * i) / 64.f);
            const float ang = (float)a.pos[m] * inv;
            float sn, cs; sincosf(ang, &sn, &cs);
            float* dst = mla ? WSP(float, WS_RMLA) + ((size_t)m * 16 + i) * 2 : WSP(float, WS_RSWA) + ((size_t)m * 32 + i) * 2;
            dst[0] = cs; dst[1] = sn;
        }
    }
}

__device__ __forceinline__ void p2_token_local(Frame& F, const Args& a) {
    const int gw = F.vcu * NWAVES + F.wave, NGW = F.G * NWAVES, lane = F.lane;
    for (int m = gw; m < M; m += NGW) {
        bf16* pr = WSP(bf16, WS_PROJ) + (size_t)m * LDP;
        {
            const v2u w = *(const v2u*)(pr + PC_CQ + 4 * lane);
            float v0 = bflo(w.x), v1 = bfhi(w.x), v2 = bflo(w.y), v3 = bfhi(w.y);
            const float rstd = 1.f / sqrtf(wave_sum(v0 * v0 + v1 * v1 + v2 * v2 + v3 * v3) * (1.f / 256.f) + EPS);
            const f32x4 g = *(const f32x4*)(a.g_mla_q + 4 * lane);
            v2u o; o.x = pk2(v0 * rstd * g.x, v1 * rstd * g.y); o.y = pk2(v2 * rstd * g.z, v3 * rstd * g.w);
            *(v2u*)(pr + PC_CQ + 4 * lane) = o;
        }
        {
            const unsigned w = *(const unsigned*)(pr + PC_CKV + 2 * lane);
            float v0 = bflo(w), v1 = bfhi(w);
            const float rstd = 1.f / sqrtf(wave_sum(v0 * v0 + v1 * v1) * (1.f / 128.f) + EPS);
            *(unsigned*)(pr + PC_CKV + 2 * lane) = pk2(v0 * rstd * a.g_mla_kv[2 * lane], v1 * rstd * a.g_mla_kv[2 * lane + 1]);
        }
        if (lane < 16) {
            const float x1 = bf2f(pr[PC_KR + lane]), x2 = bf2f(pr[PC_KR + 16 + lane]);
            const float* t = WSP(float, WS_RMLA) + ((size_t)m * 16 + lane) * 2; const float c = t[0], s = t[1];
            pr[PC_KR + lane] = (bf16)f2bf(x1 * c - x2 * s); pr[PC_KR + 16 + lane] = (bf16)f2bf(x2 * c + x1 * s);
        }
        const int i = lane & 31;
        const float* t = WSP(float, WS_RSWA) + ((size_t)m * 32 + i) * 2; const float c = t[0], s = t[1];
#pragma unroll
        for (int j = 0; j < 4; ++j) {
            const int h = (lane + 64 * j) >> 5; bf16* q = pr + PC_QS + h * 64 + i;
            const float x1 = bf2f(q[0]), x2 = bf2f(q[32]);
            q[0] = (bf16)f2bf((x1 * c - x2 * s) * C_SWA); q[32] = (bf16)f2bf((x2 * c + x1 * s) * C_SWA);
        }
        {
            bf16* k = pr + PC_KS + (lane >> 5) * 64 + i;
            const float x1 = bf2f(k[0]), x2 = bf2f(k[32]);
            k[0] = (bf16)f2bf(x1 * c - x2 * s); k[32] = (bf16)f2bf(x2 * c + x1 * s);
        }
    }
}

__device__ __forceinline__ void p7_router(Frame& F, const Args& a) {
    const int lane = F.lane, wave = F.wave, tid = F.tid;
    LAS float* hs = (LAS float*)(F.lds) + wave * 4096;
    LAS int* e_arr = (LAS int*)(F.lds + SMALL_OFF);
    const float* H = WSP(float, WS_H);
    for (int c = F.vcu; c < NCHUNK; c += F.G) {
        for (int r = 0; r < 2; ++r) {
            const int tl0 = wave * 8 + r * 4;
#pragma unroll
            for (int q = 0; q < 4; ++q) {
                const int t = c * 64 + tl0 + q;
                const GAS f32x4* xr = (const GAS f32x4*)(H + (size_t)t * D) + lane; const GAS f32x4* gr = (const GAS f32x4*)a.g_ffn + lane;
                f32x4 v[4]; float s = 0.f;
#pragma unroll
                for (int j = 0; j < 4; ++j) { v[j] = xr[64 * j]; s += (v[j].x * v[j].x + v[j].y * v[j].y) + (v[j].z * v[j].z + v[j].w * v[j].w); }
                const float rstd = 1.f / sqrtf(wave_sum(s) * (1.f / D) + EPS);
                GAS unsigned long long* o8 = (GAS unsigned long long*)(WSP(bf16, WS_XN) + (size_t)t * D) + lane;
#pragma unroll
                for (int j = 0; j < 4; ++j) { const f32x4 gg = gr[64 * j]; f32x4 y; y.x = v[j].x * rstd * gg.x; y.y = v[j].y * rstd * gg.y; y.z = v[j].z * rstd * gg.z; y.w = v[j].w * rstd * gg.w;
                    o8[64 * j] = (unsigned long long)pk2(y.x, y.y) | ((unsigned long long)pk2(y.z, y.w) << 32);
                    *(LAS f32x4*)(hs + q * 1024 + 4 * (64 * j + lane)) = y; }
            }
            LDS_WAIT(); asm volatile("" ::: "memory");
            const int e = lane & 31, half = lane >> 5;
            float acc[4] = {0.f, 0.f, 0.f, 0.f};
            const float* wr = a.w_router + (size_t)(half * 512) * NE + e;
            const LAS float* hh = hs + half * 512;
#pragma unroll 4
            for (int kk = 0; kk < 512; ++kk) { const float w = wr[(size_t)kk * NE];
#pragma unroll
                for (int q = 0; q < 4; ++q) acc[q] += hh[q * 1024 + kk] * w; }
            const float br = a.b_router[e];
#pragma unroll
            for (int q = 0; q < 4; ++q) {
                float lg = acc[q] + __shfl_xor(acc[q], 32) + br;
                float tv[4]; int ti[4];
#pragma unroll
                for (int k = 0; k < 4; ++k) {
                    float v = lg; int idx = e;
#pragma unroll
                    for (int o = 1; o < 32; o <<= 1) { const float ov = __shfl_xor(v, o); const int oi = __shfl_xor(idx, o); if (ov > v || (ov == v && oi < idx)) { v = ov; idx = oi; } }
                    tv[k] = v; ti[k] = idx; if (e == idx) lg = -INFINITY;
                }
                const float e1 = __expf(tv[1] - tv[0]), e2 = __expf(tv[2] - tv[0]), e3 = __expf(tv[3] - tv[0]); const float inv = 1.f / (1.f + e1 + e2 + e3);
                if (lane == 0) { const int tl = tl0 + q; const int t = c * 64 + tl;
                    int* te = WSP(int, WS_TKE) + (size_t)t * 4; float* tw = WSP(float, WS_TKW) + (size_t)t * 4;
                    te[0] = ti[0]; te[1] = ti[1]; te[2] = ti[2]; te[3] = ti[3]; tw[0] = inv; tw[1] = e1 * inv; tw[2] = e2 * inv; tw[3] = e3 * inv;
                    e_arr[tl * 4 + 0] = ti[0]; e_arr[tl * 4 + 1] = ti[1]; e_arr[tl * 4 + 2] = ti[2]; e_arr[tl * 4 + 3] = ti[3]; }
            }
            LDS_WAIT(); asm volatile("" ::: "memory");
        }
        __syncthreads();
        if (tid < 256) { const int e = e_arr[tid]; int rk = 0; for (int j = 0; j < tid; ++j) rk += (e_arr[j] == e) ? 1 : 0; WSP(int, WS_LRK)[(size_t)c * 256 + tid] = rk; }
        else if (tid < 256 + NE) { const int e = tid - 256; int n = 0; for (int j = 0; j < 256; ++j) n += (e_arr[j] == e) ? 1 : 0; WSP(int, WS_CNT)[c * NE + e] = n; }
        __syncthreads();
    }
}

__device__ __forceinline__ void p8_gather(Frame& F, const Args& a) {
    const int lane = F.lane, wave = F.wave, tid = F.tid;
    LAS int* cs = (LAS int*)(F.lds);
    LAS int* pre = (LAS int*)(F.lds + SMALL_OFF);
    LAS int* tot = pre + 32; LAS int* pst = pre + 64;
    bf16* XG = WSP(bf16, WS_PROJ); const bf16* HN = WSP(bf16, WS_XN);
    for (int c = F.vcu; c < NCHUNK; c += F.G) {
        for (int i = tid; i < NCHUNK * NE; i += NWAVES * 64) cs[i] = WSP(int, WS_CNT)[i];
        __syncthreads();
        if (tid < NE) { int p = 0, t = 0; for (int cc = 0; cc < NCHUNK; ++cc) { const int v = cs[cc * NE + tid]; if (cc < c) p += v; t += v; } pre[tid] = p; tot[tid] = t; }
        __syncthreads();
        if (tid == 0) { int ps = 0; for (int e = 0; e < NE; ++e) { pst[e] = ps; const int np = (tot[e] + 255) & ~255;
                if (c == 0) for (int tl = ps >> 8; tl < (ps + np) >> 8; ++tl) WSP(int, WS_TILE)[64 + tl] = e;
                ps += np; }
            if (c == 0) WSP(int, WS_TILE)[0] = ps >> 8; }
        __syncthreads();
        for (int i = wave * 32; i < wave * 32 + 32; ++i) {
            const int t = c * 64 + (i >> 2), k = i & 3;
            const int e = WSP(int, WS_TKE)[(size_t)t * 4 + k];
            const int row = pst[e] + pre[e] + WSP(int, WS_LRK)[(size_t)c * 256 + i];
            const GAS v4u* src = (const GAS v4u*)(HN + (size_t)t * D); GAS v4u* dst = (GAS v4u*)(XG + (size_t)row * D);
            const v4u x0 = src[lane], x1 = src[64 + lane]; dst[lane] = x0; dst[64 + lane] = x1;
            if (lane == 0) { WSP(float, WS_ROWW)[row] = WSP(float, WS_TKW)[(size_t)t * 4 + k]; WSP(int, WS_TKR)[(size_t)t * 4 + k] = row; }
        }
        __syncthreads();
    }
}

__device__ __forceinline__ void p11_combine(Frame& F, const Args& a) {
    const int gw = F.vcu * NWAVES + F.wave, NGW = F.G * NWAVES, lane = F.lane;
    const bf16* Y = WSP(bf16, WS_PROJ);
    for (int m = gw; m < M; m += NGW) {
        const GAS f32x4* xr = (const GAS f32x4*)(WSP(float, WS_H) + (size_t)m * D) + lane; const GAS f32x4* gr = (const GAS f32x4*)a.g_final + lane;
        f32x4 v[4];
#pragma unroll
        for (int j = 0; j < 4; ++j) v[j] = xr[64 * j];
#pragma unroll
        for (int k = 0; k < 4; ++k) { const int row = WSP(int, WS_TKR)[(size_t)m * 4 + k]; const GAS v2u* yr = (const GAS v2u*)(Y + (size_t)row * D) + lane;
#pragma unroll
            for (int j = 0; j < 4; ++j) { const v2u w = yr[64 * j]; v[j].x += bflo(w.x); v[j].y += bfhi(w.x); v[j].z += bflo(w.y); v[j].w += bfhi(w.y); } }
        float s = 0.f;
#pragma unroll
        for (int j = 0; j < 4; ++j) s += (v[j].x * v[j].x + v[j].y * v[j].y) + (v[j].z * v[j].z + v[j].w * v[j].w);
        const float rstd = 1.f / sqrtf(wave_sum(s) * (1.f / D) + EPS);
        GAS f32x4* o = (GAS f32x4*)(a.out + (size_t)m * D) + lane;
#pragma unroll
        for (int j = 0; j < 4; ++j) { const f32x4 gg = gr[64 * j]; f32x4 y; y.x = v[j].x * rstd * gg.x; y.y = v[j].y * rstd * gg.y; y.z = v[j].z * rstd * gg.z; y.w = v[j].w * rstd * gg.w; o[64 * j] = y; }
    }
}

namespace att {
using s16x4  = __attribute__((ext_vector_type(4))) short;
using f32x16 = __attribute__((ext_vector_type(16))) float;
using u32x4  = __attribute__((ext_vector_type(4))) unsigned;
#define KSWZ(row, colB) ((row) * 256 + ((colB) ^ (((row) & 7) << 4)))
#define SBAR() __builtin_amdgcn_sched_barrier(0)
constexpr float THR2 = 8.f;
__device__ __forceinline__ int crow(int r, int hi) { return (r & 3) + 8 * (r >> 2) + 4 * hi; }
__device__ __forceinline__ unsigned cvtpk(float lo, float hi) { unsigned r; asm volatile("v_cvt_pk_bf16_f32 %0, %1, %2" : "=v"(r) : "v"(lo), "v"(hi)); return r; }
template <int NCB> __device__ __forceinline__ int v_st(int k, int c) { const int kk = (k & ~0xC) | ((k & 4) << 1) | ((k & 8) >> 1); return ((kk >> 3) * NCB + (c >> 5)) * 512 + ((kk & 7) * 32 + (c & 31)) * 2; }
__device__ __forceinline__ int v_rd_base(int lane) { return ((lane & 3) << 3) | (((lane >> 2) & 3) << 6) | (((lane >> 4) & 1) << 5) | (((lane >> 5) & 1) << 8); }
template <int OFF> __device__ __forceinline__ s16x4 tr_read(int vb) { s16x4 r; asm volatile("ds_read_b64_tr_b16 %0, %1 offset:%2" : "=&v"(r) : "v"(vb), "i"(OFF) : "memory"); return r; }

template <int MODE> __device__ __forceinline__ void partialSM(f32x16& p0, f32x16& p1, float& m_reg, float& mn, float& alpha, bool domask, int kb, int qrow, int hi) {
    if (MODE != 2 && domask) {
#pragma unroll
        for (int r = 0; r < 16; ++r) { const int k0 = kb + crow(r, hi), k1 = k0 + 32;
            if (k0 > qrow || (MODE == 1 && k0 < qrow - 127)) p0[r] = -INFINITY;
            if (k1 > qrow || (MODE == 1 && k1 < qrow - 127)) p1[r] = -INFINITY; }
    }
    float pmax = p0[0];
#pragma unroll
    for (int r = 1; r < 16; ++r) pmax = fmaxf(pmax, p0[r]);
#pragma unroll
    for (int r = 0; r < 16; ++r) pmax = fmaxf(pmax, p1[r]);
    { auto rr = __builtin_amdgcn_permlane32_swap(__float_as_uint(pmax), __float_as_uint(pmax), false, false); pmax = fmaxf(__uint_as_float(rr[0]), __uint_as_float(rr[1])); }
    if (__builtin_expect(__all(pmax - m_reg <= THR2), 1)) { mn = m_reg; alpha = 1.f; }
    else { mn = fmaxf(m_reg, pmax); alpha = __builtin_amdgcn_exp2f(m_reg - mn); m_reg = mn; }
#pragma unroll
    for (int r = 0; r < 16; ++r) p0[r] = p0[r] - mn;
#pragma unroll
    for (int r = 0; r < 16; ++r) p1[r] = p1[r] - mn;
#pragma unroll
    for (int r = 0; r < 16; ++r) p0[r] = __builtin_amdgcn_exp2f(p0[r]);
}
__device__ __forceinline__ void finishSM(f32x16& p0, f32x16& p1, float alpha, float& l_reg, bf16x8& pa0, bf16x8& pa1, bf16x8& pa2, bf16x8& pa3) {
#pragma unroll
    for (int r = 0; r < 16; ++r) p1[r] = __builtin_amdgcn_exp2f(p1[r]);
    float ps = 0;
#pragma unroll
    for (int r = 0; r < 16; ++r) ps += p0[r];
#pragma unroll
    for (int r = 0; r < 16; ++r) ps += p1[r];
    { auto rr = __builtin_amdgcn_permlane32_swap(__float_as_uint(ps), __float_as_uint(ps), false, false); ps = __uint_as_float(rr[0]) + __uint_as_float(rr[1]); }
    l_reg = l_reg * alpha + ps;
#define PK4(P, BASE, OUT) do { unsigned a0 = cvtpk(P[BASE + 0], P[BASE + 1]), a1 = cvtpk(P[BASE + 2], P[BASE + 3]);   \
    unsigned b0 = cvtpk(P[BASE + 4], P[BASE + 5]), b1 = cvtpk(P[BASE + 6], P[BASE + 7]);                              \
    auto r0 = __builtin_amdgcn_permlane32_swap(a0, b0, false, false); auto r1 = __builtin_amdgcn_permlane32_swap(a1, b1, false, false); \
    u32x4 w = {r0[0], r1[0], r0[1], r1[1]}; OUT = *reinterpret_cast<bf16x8*>(&w); } while (0)
    PK4(p0, 0, pa0); PK4(p0, 8, pa1); PK4(p1, 0, pa2); PK4(p1, 8, pa3);
#undef PK4
}
template <int ND0> __device__ __forceinline__ void qkt(f32x16& p0, f32x16& p1, const char* Ks, const bf16x8* qr, int r32, int hi) {
    p0 = f32x16{}; p1 = f32x16{};
#pragma unroll
    for (int d0 = 0; d0 < ND0; ++d0) { const int cb = (d0 * 16 + hi * 8) * 2;
        const bf16x8 b0 = *reinterpret_cast<const bf16x8*>(Ks + KSWZ(r32, cb));
        const bf16x8 b1 = *reinterpret_cast<const bf16x8*>(Ks + KSWZ(32 + r32, cb));
        p0 = __builtin_amdgcn_mfma_f32_32x32x16_bf16(b0, qr[d0], p0, 0, 0, 0);
        p1 = __builtin_amdgcn_mfma_f32_32x32x16_bf16(b1, qr[d0], p1, 0, 0, 0); }
}
template <int NCB, int D0> __device__ __forceinline__ void pv_one(f32x16& od, int vb, bf16x8 pa0, bf16x8 pa1, bf16x8 pa2, bf16x8 pa3) {
    constexpr int KS = 2 * NCB * 512, HF = NCB * 512;
    const s16x4 l0 = tr_read<D0 * 512 + 0 * KS>(vb), h0 = tr_read<D0 * 512 + 0 * KS + HF>(vb), l1 = tr_read<D0 * 512 + 1 * KS>(vb), h1 = tr_read<D0 * 512 + 1 * KS + HF>(vb);
    const s16x4 l2 = tr_read<D0 * 512 + 2 * KS>(vb), h2 = tr_read<D0 * 512 + 2 * KS + HF>(vb), l3 = tr_read<D0 * 512 + 3 * KS>(vb), h3 = tr_read<D0 * 512 + 3 * KS + HF>(vb);
    asm volatile("s_waitcnt lgkmcnt(0)" ::: "memory"); SBAR();
#define PK(L, H) (bf16x8){L[0], L[1], L[2], L[3], H[0], H[1], H[2], H[3]}
    od = __builtin_amdgcn_mfma_f32_32x32x16_bf16(pa0, PK(l0, h0), od, 0, 0, 0);
    od = __builtin_amdgcn_mfma_f32_32x32x16_bf16(pa1, PK(l1, h1), od, 0, 0, 0);
    od = __builtin_amdgcn_mfma_f32_32x32x16_bf16(pa2, PK(l2, h2), od, 0, 0, 0);
    od = __builtin_amdgcn_mfma_f32_32x32x16_bf16(pa3, PK(l3, h3), od, 0, 0, 0);
#undef PK
}
template <int NCB> __device__ __forceinline__ void pv_all(f32x16* o, int vb, bf16x8 pa0, bf16x8 pa1, bf16x8 pa2, bf16x8 pa3) {
    pv_one<NCB, 0>(o[0], vb, pa0, pa1, pa2, pa3); pv_one<NCB, 1>(o[1], vb, pa0, pa1, pa2, pa3);
    if constexpr (NCB == 4) { pv_one<NCB, 2>(o[2], vb, pa0, pa1, pa2, pa3); pv_one<NCB, 3>(o[3], vb, pa0, pa1, pa2, pa3); }
}

template <int MODE> __device__ __forceinline__ void attn_unit(const Args& a, int b, int h, int qb, char* lds) {
    constexpr int DQK = MODE == 0 ? 96 : (MODE == 1 ? 64 : 128), DV = MODE == 2 ? 128 : 64, ND0 = DQK / 16, NCB = DV / 32;
    constexpr int SHM_V = 64 * DV * 2, SHM_K = 64 * 256;
    unsigned char* ws = a.ws;
    const bf16* PROJ = (const bf16*)(ws + WS_PROJ); const bf16* KVMLA = (const bf16*)(ws + WS_KVMLA); const bf16* KVMEM = (const bf16*)(ws + WS_KVMEM); const bf16* QMLA = (const bf16*)(ws + WS_QMLA);
    const int tid = threadIdx.x, wid = tid >> 6, lane = tid & 63, r32 = lane & 31, hi = lane >> 5;
    char* V_lds = lds; char* K_lds = lds + 2 * SHM_V;
    float* wsf = (float*)(lds + 65536) + wid * 64; float* li_l = wsf; float* al_l = wsf + 32;
    const int q0 = qb * 256, qrow = q0 + wid * 32 + r32; const size_t m = (size_t)b * SEQ + qrow;
    float m_reg = -1e30f, l_reg = 0.f; f32x16 o[NCB]; bf16x8 qr[ND0];
#pragma unroll
    for (int d = 0; d < NCB; ++d) o[d] = f32x16{};
    {
        const bf16* Qw = MODE == 0 ? QMLA + m * 768 + h * 96 + hi * 8 : (MODE == 1 ? PROJ + m * LDP + PC_QS + h * 64 + hi * 8 : PROJ + m * LDP + PC_QX + h * 128 + hi * 8);
#pragma unroll
        for (int d0 = 0; d0 < ND0; ++d0) qr[d0] = *reinterpret_cast<const bf16x8*>(Qw + d0 * 16);
        if constexpr (MODE == 0) {
            const float* t = (const float*)(ws + WS_RMLA) + (m * 16 + 8 * hi) * 2;
            u32x4 n1, n2; float y1[8], y2[8];
#pragma unroll
            for (int j = 0; j < 8; ++j) { const float c = t[2 * j], s = t[2 * j + 1];
                const float x1 = __builtin_bit_cast(float, (unsigned)(unsigned short)qr[4][j] << 16), x2 = __builtin_bit_cast(float, (unsigned)(unsigned short)qr[5][j] << 16);
                y1[j] = x1 * c - x2 * s; y2[j] = x2 * c + x1 * s; }
            n1.x = cvtpk(y1[0], y1[1]); n1.y = cvtpk(y1[2], y1[3]); n1.z = cvtpk(y1[4], y1[5]); n1.w = cvtpk(y1[6], y1[7]);
            n2.x = cvtpk(y2[0], y2[1]); n2.y = cvtpk(y2[2], y2[3]); n2.z = cvtpk(y2[4], y2[5]); n2.w = cvtpk(y2[6], y2[7]);
            qr[4] = *reinterpret_cast<bf16x8*>(&n1); qr[5] = *reinterpret_cast<bf16x8*>(&n2);
        }
    }
    const int key0 = MODE == 1 ? (q0 >= 128 ? q0 - 128 : 0) : 0;
    const int NT = MODE == 0 ? 4 * (qb + 1) : (MODE == 1 ? (qb == 0 ? 4 : 6) : 4);
    const int sr8 = tid >> 3, sc8 = tid & 7;
    const int sr4 = (tid >> 2) & 63, sc4 = tid & 3;
    const int sr = tid >> 4, sc = (tid & 15) * 8;
    const size_t krow0 = (size_t)b * (MODE == 2 ? MEML : SEQ) + key0;
    const int vb0 = (int)(uintptr_t)V_lds + v_rd_base(lane);
    struct { bf16x8 ks0, ks1, vs0, vs1; } st_[2];
#define SLOAD(i, t) do { const size_t kr_ = krow0 + (size_t)(t) * 64;                                                                      \
        if constexpr (MODE == 0) { st_[i].ks0 = *reinterpret_cast<const bf16x8*>(KVMLA + (kr_ + sr8) * 1024 + h * 128 + sc8 * 8);          \
            st_[i].vs0 = *reinterpret_cast<const bf16x8*>(KVMLA + (kr_ + sr8) * 1024 + h * 128 + 64 + sc8 * 8);                           \
            if (tid < 256) st_[i].ks1 = *reinterpret_cast<const bf16x8*>(PROJ + (kr_ + sr4) * LDP + PC_KR + sc4 * 8); }                   \
        else if constexpr (MODE == 1) { st_[i].ks0 = *reinterpret_cast<const bf16x8*>(PROJ + (kr_ + sr8) * LDP + PC_KS + (h >> 2) * 64 + sc8 * 8); \
            st_[i].vs0 = *reinterpret_cast<const bf16x8*>(PROJ + (kr_ + sr8) * LDP + PC_VS + (h >> 2) * 64 + sc8 * 8); }                  \
        else { st_[i].ks0 = *reinterpret_cast<const bf16x8*>(KVMEM + (kr_ + sr) * 1024 + h * 128 + sc);                                    \
            st_[i].ks1 = *reinterpret_cast<const bf16x8*>(KVMEM + (kr_ + 32 + sr) * 1024 + h * 128 + sc);                                  \
            st_[i].vs0 = *reinterpret_cast<const bf16x8*>(KVMEM + (kr_ + sr) * 1024 + 512 + h * 128 + sc);                                \
            st_[i].vs1 = *reinterpret_cast<const bf16x8*>(KVMEM + (kr_ + 32 + sr) * 1024 + 512 + h * 128 + sc); } } while (0)
#define SWRITE(bf, i) do {                                                                                                                 \
        if constexpr (MODE == 0) { *(bf16x8*)(K_lds + (bf) * SHM_K + KSWZ(sr8, sc8 * 16)) = st_[i].ks0;                                    \
            *(bf16x8*)(V_lds + (bf) * SHM_V + v_st<NCB>(sr8, sc8 * 8)) = st_[i].vs0;                                                       \
            if (tid < 256) *(bf16x8*)(K_lds + (bf) * SHM_K + KSWZ(sr4, 128 + sc4 * 16)) = st_[i].ks1; }                                    \
        else if constexpr (MODE == 1) { *(bf16x8*)(K_lds + (bf) * SHM_K + KSWZ(sr8, sc8 * 16)) = st_[i].ks0;                               \
            *(bf16x8*)(V_lds + (bf) * SHM_V + v_st<NCB>(sr8, sc8 * 8)) = st_[i].vs0; }                                                     \
        else { *(bf16x8*)(K_lds + (bf) * SHM_K + KSWZ(sr, sc * 2)) = st_[i].ks0; *(bf16x8*)(K_lds + (bf) * SHM_K + KSWZ(32 + sr, sc * 2)) = st_[i].ks1; \
            *(bf16x8*)(V_lds + (bf) * SHM_V + v_st<NCB>(sr, sc)) = st_[i].vs0; *(bf16x8*)(V_lds + (bf) * SHM_V + v_st<NCB>(32 + sr, sc)) = st_[i].vs1; } } while (0)
#define SWAIT() do { if constexpr (MODE == 2) asm volatile("s_waitcnt vmcnt(4)" ::: "memory"); else asm volatile("s_waitcnt vmcnt(2)" ::: "memory"); } while (0)
#define RESC(al) do { if (__any((al) < 1.f)) { if (hi == 0) al_l[r32] = (al); asm volatile("s_waitcnt lgkmcnt(0)" ::: "memory");            \
        _Pragma("unroll") for (int d = 0; d < NCB; ++d) _Pragma("unroll") for (int r = 0; r < 16; ++r) o[d][r] *= al_l[crow(r, hi)]; } } while (0)
#define DOMASK(t) (MODE == 1 || (MODE == 0 && (t) >= NT - 4))
    f32x16 pA0, pA1, pB0, pB1; float mnA, mnB, alA, alB; bf16x8 pa0, pa1, pa2, pa3;
    SLOAD(0, 0); asm volatile("s_waitcnt vmcnt(0)" ::: "memory"); SWRITE(0, 0); __syncthreads();
    qkt<ND0>(pA0, pA1, K_lds, qr, r32, hi); partialSM<MODE>(pA0, pA1, m_reg, mnA, alA, DOMASK(0), key0, qrow, hi);
    SLOAD(1, 1); if (2 < NT) SLOAD(0, 2);
    SWAIT(); SWRITE(1, 1); __syncthreads();
    for (int j = 1; j + 1 < NT; j += 2) {
        SBAR(); qkt<ND0>(pB0, pB1, K_lds + SHM_K, qr, r32, hi);
        finishSM(pA0, pA1, alA, l_reg, pa0, pa1, pa2, pa3); SBAR();
        if (j + 2 < NT) SLOAD(1, j + 2); SBAR();
        pv_all<NCB>(o, vb0, pa0, pa1, pa2, pa3); partialSM<MODE>(pB0, pB1, m_reg, mnB, alB, DOMASK(j), key0 + 64 * j, qrow, hi);
        __syncthreads(); SWAIT(); SWRITE(0, 0);
        RESC(alB); __syncthreads();
        SBAR(); qkt<ND0>(pA0, pA1, K_lds, qr, r32, hi);
        finishSM(pB0, pB1, alB, l_reg, pa0, pa1, pa2, pa3); SBAR();
        if (j + 3 < NT) SLOAD(0, j + 3); SBAR();
        pv_all<NCB>(o, vb0 + SHM_V, pa0, pa1, pa2, pa3); partialSM<MODE>(pA0, pA1, m_reg, mnA, alA, DOMASK(j + 1), key0 + 64 * (j + 1), qrow, hi);
        __syncthreads(); SWAIT(); if (j + 2 < NT) SWRITE(1, 1);
        RESC(alA); __syncthreads();
    }
    SBAR(); qkt<ND0>(pB0, pB1, K_lds + SHM_K, qr, r32, hi);
    finishSM(pA0, pA1, alA, l_reg, pa0, pa1, pa2, pa3); SBAR();
    pv_all<NCB>(o, vb0, pa0, pa1, pa2, pa3); partialSM<MODE>(pB0, pB1, m_reg, mnB, alB, DOMASK(NT - 1), key0 + 64 * (NT - 1), qrow, hi);
    __syncthreads(); RESC(alB);
    finishSM(pB0, pB1, alB, l_reg, pa0, pa1, pa2, pa3); SBAR();
    pv_all<NCB>(o, vb0 + SHM_V, pa0, pa1, pa2, pa3);
    if constexpr (MODE == 1) l_reg += __builtin_amdgcn_exp2f(a.sinks[h] * LOG2E - m_reg);
    if (hi == 0) li_l[r32] = l_reg; asm volatile("s_waitcnt lgkmcnt(0)" ::: "memory");
    float rli[16];
#pragma unroll
    for (int r = 0; r < 16; ++r) rli[r] = __builtin_amdgcn_rcpf(li_l[crow(r, hi)]);
    __syncthreads();
    bf16* stg = (bf16*)(lds + wid * (32 * DV * 2));
#pragma unroll
    for (int r = 0; r < 16; ++r) { const int orow = crow(r, hi);
#pragma unroll
        for (int d0 = 0; d0 < NCB; ++d0) stg[orow * DV + d0 * 32 + r32] = (bf16)f2bf(o[d0][r] * rli[r]); }
    asm volatile("s_waitcnt lgkmcnt(0)" ::: "memory");
    bf16* Ow = (bf16*)(ws + WS_ATT) + ((size_t)b * SEQ + q0 + wid * 32) * 1536 + (MODE == 0 ? h * 64 : (MODE == 1 ? 512 + h * 64 : 1024 + h * 128));
    constexpr int CPR = DV / 8;
#pragma unroll
    for (int i = 0; i < (32 * CPR) / 64; ++i) { const int idx = i * 64 + lane, row = idx / CPR, ch = idx % CPR;
        const u32x4 v = *(const u32x4*)(stg + row * DV + ch * 8); *(u32x4*)(Ow + (size_t)row * 1536 + ch * 8) = v; }
    asm volatile("s_waitcnt lgkmcnt(0)" ::: "memory");
    __syncthreads();
#undef SLOAD
#undef SWRITE
#undef SWAIT
#undef RESC
#undef DOMASK
}
__device__ __forceinline__ void attn_phase(const Args& a, int vcu, int G, char* lds) {
    for (int k = 0;; ++k) { const int i = vcu + (k >> 1) * G; if (i >= 256) break; const int bh = i >> 4, s = i & 15;
        attn_unit<0>(a, bh >> 3, bh & 7, (k & 1) ? s : 31 - s, lds); }
    for (int k = 0;; ++k) { const int i = vcu + (k >> 1) * G; if (i >= 256) break; const int su = 2 * i + (k & 1);
        attn_unit<1>(a, su >> 8, (su >> 5) & 7, su & 31, lds); }
    for (int i = vcu; i < 256; i += G) attn_unit<2>(a, i >> 7, (i >> 5) & 3, i & 31, lds);
}
#undef KSWZ
#undef SBAR
}

__global__ void __launch_bounds__(NWAVES * 64, 2) fwd(Args args) {
    extern __shared__ __attribute__((aligned(16))) unsigned char lds[];
    Frame F;
    F.lds = (LAS unsigned char*)lds;
    F.MISC = (volatile LAS unsigned*)(F.lds + MISC_OFF);
    F.tid = threadIdx.x; F.lane = F.tid & 63; F.wave = __builtin_amdgcn_readfirstlane(F.tid >> 6);
    F.G = gridDim.x; { const int bx = blockIdx.x; F.vcu = (F.G % 8 == 0) ? (bx % 8) * (F.G / 8) + bx / 8 : bx; }
    F.ws = args.ws; F.ctl = (gu32*)(args.ws + WS_CTL);
    for (int u = F.tid; u < (LDS_BYTES - LDSCTL_OFF) / 4; u += NWAVES * 64) ((LAS unsigned*)(F.lds + LDSCTL_OFF))[u] = 0u;
    __syncthreads();
    const int lo = args.ph_lo, hi = args.ph_hi;
    XcdBarrier bar; bar.bar = (unsigned*)(F.ctl + CW_BAR) + lo * XCD_BAR_WORDS; bar.x = 0; bar.st = nullptr;
    if (hi - lo > 1) bar = xcd_barrier_post((unsigned*)(F.ctl + CW_BAR) + lo * XCD_BAR_WORDS, F.MISC + 8);
#define IN(k) (lo <= (k) && (k) < hi)
#define SEAM(k) do { if (IN(k) && IN((k) + 1)) xcd_barrier(bar); } while (0)
    if (IN(0)) { p0_prologue(F, args); SEAM(0); }
    if (IN(1)) {
        if (FAST_MASK & (1u << 1)) {
            { pg8::Gemm g{WSP(bf16, WS_MEMN), WSP(bf16, WS_WMKV), MROWS, 1024, 1024, 1024, 1024}; pg8::TailOrder S{4, 8, F.G, (int)blockIdx.x}; pg8::EpiPlain E{WSP(bf16, WS_KVMEM), 1024, 1.f};
              pg8::gemm_phase<pg8::EpiPlain, pg8::TailOrder, true, true>(F.lds, g, S, E); }
            { pg8::Gemm g{WSP(bf16, WS_XN), WSP(bf16, WS_WIN), M, LDP, 1024, 1024, 1024}; pg8::StaticOrder S; S.init(M, LDP, F.G, (int)blockIdx.x); pg8::EpiProj E{WSP(bf16, WS_PROJ), args.b_gate, C_XA};
              pg8::gemm_phase<pg8::EpiProj, pg8::StaticOrder, true, true>(F.lds, g, S, E); }
        }
        SEAM(1); }
    if (IN(2)) { p2_token_local(F, args); SEAM(2); }
    if (IN(3)) {
        if (FAST_MASK & (1u << 3)) {
            { pg8::Gemm g{WSP(bf16, WS_PROJ) + PC_CQ, WSP(bf16, WS_WUQ), M, 768, 256, LDP, 256}; pg8::SimpleOrder S{3, 192, F.G, (int)blockIdx.x}; pg8::EpiPlain E{WSP(bf16, WS_QMLA), 768, C_MLA};
              pg8::gemm_phase<pg8::EpiPlain, pg8::SimpleOrder, true, true>(F.lds, g, S, E); }
            { pg8::Gemm g{WSP(bf16, WS_PROJ) + PC_CKV, WSP(bf16, WS_WUKV), M, 1024, 128, LDP, 128}; pg8::SimpleOrder S{4, 256, F.G, (int)blockIdx.x}; pg8::EpiPlain E{WSP(bf16, WS_KVMLA), 1024, 1.f};
              pg8::gemm_phase<pg8::EpiPlain, pg8::SimpleOrder, true, true>(F.lds, g, S, E); }
        }
        SEAM(3); }
    if (IN(4)) {
        if (FAST_MASK & (1u << 4)) att::attn_phase(args, F.vcu, F.G, (char*)lds);
        SEAM(4); }
    if (IN(5)) {
        if (FAST_MASK & (1u << 5)) {
            pg8::Gemm g{WSP(bf16, WS_ATT), WSP(bf16, WS_WO3), M, 3072, 512, 1536, 512}; pg8::Gate3Order S{F.G, (int)blockIdx.x}; pg8::EpiGate3 E{WSP(bf16, WS_PROJ), WSP(float, WS_MERGED), WSP(bf16, WS_MERGEDB)};
            pg8::gemm_phase<pg8::EpiGate3, pg8::Gate3Order, true, true>(F.lds, g, S, E);
        }
        SEAM(5); }
    if (IN(6)) {
        if (FAST_MASK & (1u << 6)) {
            pg8::Gemm g{WSP(bf16, WS_MERGEDB), WSP(bf16, WS_WOUT), M, 1024, 1024, 1024, 1024}; pg8::SimpleOrder S{4, 256, F.G, (int)blockIdx.x}; pg8::EpiResF32 E{args.x, WSP(float, WS_H)};
            pg8::gemm_phase<pg8::EpiResF32, pg8::SimpleOrder, true, true>(F.lds, g, S, E);
        }
        SEAM(6); }
    if (IN(7)) { p7_router(F, args); SEAM(7); }
    if (IN(8)) { p8_gather(F, args); SEAM(8); }
    if (IN(9)) {
        if (FAST_MASK & (1u << 9)) {
            pg8::Gemm g{WSP(bf16, WS_PROJ), WSP(bf16, WS_WGU), RMAX, NE * 2048, 1024, 1024, 1024}; pg8::MoeOrder<8> S{WSP(int, WS_TILE), F.G, (int)blockIdx.x}; pg8::EpiSwiglu E{WSP(bf16, WS_HDN), args.b_gu};
            pg8::gemm_phase<pg8::EpiSwiglu, pg8::MoeOrder<8>, true, true>(F.lds, g, S, E);
        }
        SEAM(9); }
    if (IN(10)) {
        if (FAST_MASK & (1u << 10)) {
            pg8::Gemm g{WSP(bf16, WS_HDN), WSP(bf16, WS_WDN), RMAX, NE * 1024, 1024, 1024, 1024}; pg8::MoeOrder<4> S{WSP(int, WS_TILE), F.G, (int)blockIdx.x}; pg8::EpiDown E{WSP(bf16, WS_PROJ), args.b_dn, WSP(float, WS_ROWW)};
            pg8::gemm_phase<pg8::EpiDown, pg8::MoeOrder<4>, true, true>(F.lds, g, S, E);
        }
        SEAM(10); }
    if (IN(11)) { p11_combine(F, args); }
#undef IN
#undef SEAM
}

__device__ __forceinline__ void nv_tile(const bf16* A, int lda, int row0, int nrows, const float* W, int ldw, int col0, int ncols, int K, float (&acc)[4][4], float* As, float* Ws) {
    const int tid = threadIdx.x, ty = tid >> 4, tx = tid & 15;
    for (int k0 = 0; k0 < K; k0 += 16) {
        { const int r = row0 + (tid >> 2), kq = (tid & 3) * 4; v2u w; w.x = 0u; w.y = 0u; if (r < nrows) w = *(const v2u*)(A + (size_t)r * lda + k0 + kq);
          As[(kq + 0) * 68 + (tid >> 2)] = bflo(w.x); As[(kq + 1) * 68 + (tid >> 2)] = bfhi(w.x); As[(kq + 2) * 68 + (tid >> 2)] = bflo(w.y); As[(kq + 3) * 68 + (tid >> 2)] = bfhi(w.y); }
        { const int kk = tid >> 4, c4 = (tid & 15) * 4; f32x4 w = {0.f, 0.f, 0.f, 0.f}; if (col0 + c4 < ncols) w = *(const f32x4*)(W + (size_t)(k0 + kk) * ldw + col0 + c4);
          *(f32x4*)(Ws + kk * 64 + c4) = w; }
        __syncthreads();
#pragma unroll
        for (int kk = 0; kk < 16; ++kk) { const f32x4 av = *(const f32x4*)(As + kk * 68 + ty * 4); const f32x4 bv = *(const f32x4*)(Ws + kk * 64 + tx * 4);
#pragma unroll
            for (int i = 0; i < 4; ++i)
#pragma unroll
                for (int j = 0; j < 4; ++j) acc[i][j] += av[i] * bv[j]; }
        __syncthreads();
    }
}
#define NV_ZERO(acc) do { _Pragma("unroll") for (int i_ = 0; i_ < 4; ++i_) _Pragma("unroll") for (int j_ = 0; j_ < 4; ++j_) acc[i_][j_] = 0.f; } while (0)
enum { NV_PROJ = 1, NV_KVMEM, NV_QMLA, NV_KVMLA, NV_OUT3, NV_WOUT, NV_GU, NV_DN };
template <int ST> __global__ void __launch_bounds__(256) nv_gemm(Args a) {
    __shared__ __attribute__((aligned(16))) float As[16 * 68]; __shared__ __attribute__((aligned(16))) float Ws[16 * 64];
    unsigned char* ws = a.ws;
    const int tid = threadIdx.x, ty = tid >> 4, tx = tid & 15, row0 = blockIdx.y * 64, col0 = blockIdx.x * 64;
    float acc[4][4]; NV_ZERO(acc);
    if constexpr (ST == NV_PROJ) {
        nv_tile((const bf16*)(ws + WS_XN), D, row0, M, a.w_in, NPSRC, col0, NPSRC, D, acc, As, Ws);
        bf16* P = (bf16*)(ws + WS_PROJ);
        for (int i = 0; i < 4; ++i) for (int j = 0; j < 4; ++j) { const int r = row0 + ty * 4 + i, sc = col0 + tx * 4 + j; if (sc >= NPSRC) continue;
            float v = acc[i][j]; if (sc >= SC_G) v = 1.f / (1.f + __expf(-(v + a.b_gate[sc - SC_G]))); else if (sc >= SC_QX) v *= C_XA;
            P[(size_t)r * LDP + (sc < 416 ? sc : sc + 96)] = (bf16)f2bf(v); }
    } else if constexpr (ST == NV_KVMEM) {
        nv_tile((const bf16*)(ws + WS_MEMN), D, row0, MROWS, a.w_mem_kv, 1024, col0, 1024, D, acc, As, Ws);
        bf16* O = (bf16*)(ws + WS_KVMEM);
        for (int i = 0; i < 4; ++i) for (int j = 0; j < 4; ++j) O[(size_t)(row0 + ty * 4 + i) * 1024 + col0 + tx * 4 + j] = (bf16)f2bf(acc[i][j]);
    } else if constexpr (ST == NV_QMLA) {
        nv_tile((const bf16*)(ws + WS_PROJ) + PC_CQ, LDP, row0, M, a.w_uq, 768, col0, 768, 256, acc, As, Ws);
        bf16* O = (bf16*)(ws + WS_QMLA);
        for (int i = 0; i < 4; ++i) for (int j = 0; j < 4; ++j) O[(size_t)(row0 + ty * 4 + i) * 768 + col0 + tx * 4 + j] = (bf16)f2bf(acc[i][j] * C_MLA);
    } else if constexpr (ST == NV_KVMLA) {
        nv_tile((const bf16*)(ws + WS_PROJ) + PC_CKV, LDP, row0, M, a.w_ukv, 1024, col0, 1024, 128, acc, As, Ws);
        bf16* O = (bf16*)(ws + WS_KVMLA);
        for (int i = 0; i < 4; ++i) for (int j = 0; j < 4; ++j) O[(size_t)(row0 + ty * 4 + i) * 1024 + col0 + tx * 4 + j] = (bf16)f2bf(acc[i][j]);
    } else if constexpr (ST == NV_OUT3) {
        float tot[4][4]; NV_ZERO(tot);
        const bf16* P = (const bf16*)(ws + WS_PROJ);
        for (int b = 0; b < 3; ++b) {
            NV_ZERO(acc);
            const float* w = b == 0 ? a.w_mla_o : (b == 1 ? a.w_swa_o : a.w_xa_o);
            nv_tile((const bf16*)(ws + WS_ATT) + b * 512, 1536, row0, M, w, 1024, col0, 1024, 512, acc, As, Ws);
            for (int i = 0; i < 4; ++i) for (int j = 0; j < 4; ++j) tot[i][j] += acc[i][j] * bf2f(P[(size_t)(row0 + ty * 4 + i) * LDP + PC_G + b * 1024 + col0 + tx * 4 + j]);
        }
        bf16* O = (bf16*)(ws + WS_MERGEDB);
        for (int i = 0; i < 4; ++i) for (int j = 0; j < 4; ++j) O[(size_t)(row0 + ty * 4 + i) * 1024 + col0 + tx * 4 + j] = (bf16)f2bf(tot[i][j]);
    } else if constexpr (ST == NV_WOUT) {
        nv_tile((const bf16*)(ws + WS_MERGEDB), 1024, row0, M, a.w_out, 1024, col0, 1024, 1024, acc, As, Ws);
        float* O = (float*)(ws + WS_H);
        for (int i = 0; i < 4; ++i) for (int j = 0; j < 4; ++j) { const size_t o = (size_t)(row0 + ty * 4 + i) * 1024 + col0 + tx * 4 + j; O[o] = a.x[o] + acc[i][j]; }
    } else if constexpr (ST == NV_GU) {
        const int* tile = (const int*)(ws + WS_TILE); const int nt = tile[0]; if (row0 >= nt * 256) return;
        const int e = tile[64 + (row0 >> 8)];
        float acl[4][4]; NV_ZERO(acl);
        const float* w = a.w_gu + (size_t)e * 1024 * 2048;
        nv_tile((const bf16*)(ws + WS_PROJ), 1024, row0, RMAX, w, 2048, col0, 2048, 1024, acc, As, Ws);
        nv_tile((const bf16*)(ws + WS_PROJ), 1024, row0, RMAX, w, 2048, 1024 + col0, 2048, 1024, acl, As, Ws);
        bf16* O = (bf16*)(ws + WS_HDN);
        for (int i = 0; i < 4; ++i) for (int j = 0; j < 4; ++j) { const int c = col0 + tx * 4 + j;
            const float g = fminf(acc[i][j] + a.b_gu[e * 2048 + c], 7.f), l = fminf(fmaxf(acl[i][j] + a.b_gu[e * 2048 + 1024 + c], -7.f), 7.f);
            O[(size_t)(row0 + ty * 4 + i) * 1024 + c] = (bf16)f2bf(g / (1.f + __expf(-1.702f * g)) * (l + 1.f)); }
    } else if constexpr (ST == NV_DN) {
        const int* tile = (const int*)(ws + WS_TILE); const int nt = tile[0]; if (row0 >= nt * 256) return;
        const int e = tile[64 + (row0 >> 8)];
        nv_tile((const bf16*)(ws + WS_HDN), 1024, row0, RMAX, a.w_dn + (size_t)e * 1024 * 1024, 1024, col0, 1024, 1024, acc, As, Ws);
        bf16* O = (bf16*)(ws + WS_PROJ); const float* rw = (const float*)(ws + WS_ROWW);
        for (int i = 0; i < 4; ++i) for (int j = 0; j < 4; ++j) { const int r = row0 + ty * 4 + i, c = col0 + tx * 4 + j;
            O[(size_t)r * 1024 + c] = (bf16)f2bf((acc[i][j] + a.b_dn[e * 1024 + c]) * rw[r]); }
    }
}

template <int MODE> __global__ void __launch_bounds__(128) nv_attn(Args a) {
    constexpr int DQK = MODE == 0 ? 96 : (MODE == 1 ? 64 : 128), DV = 64;
    __shared__ float Ks[32 * DQK]; __shared__ float Vs[32 * DV];
    unsigned char* ws = a.ws;
    const bf16* PROJ = (const bf16*)(ws + WS_PROJ); const bf16* KVMLA = (const bf16*)(ws + WS_KVMLA); const bf16* KVMEM = (const bf16*)(ws + WS_KVMEM); const bf16* QMLA = (const bf16*)(ws + WS_QMLA);
    const int tid = threadIdx.x, b = blockIdx.z, q0 = blockIdx.x * 128, qi = q0 + tid; const size_t m = (size_t)b * SEQ + qi;
    const int h = MODE == 2 ? blockIdx.y >> 1 : blockIdx.y, vh = MODE == 2 ? (blockIdx.y & 1) : 0;
    float q[DQK];
    if constexpr (MODE == 0) {
#pragma unroll
        for (int d = 0; d < 64; ++d) q[d] = bf2f(QMLA[m * 768 + h * 96 + d]);
#pragma unroll
        for (int i = 0; i < 16; ++i) { const float x1 = bf2f(QMLA[m * 768 + h * 96 + 64 + i]), x2 = bf2f(QMLA[m * 768 + h * 96 + 80 + i]);
            const float* t = (const float*)(ws + WS_RMLA) + (m * 16 + i) * 2; q[64 + i] = x1 * t[0] - x2 * t[1]; q[80 + i] = x2 * t[0] + x1 * t[1]; }
    } else if constexpr (MODE == 1) {
#pragma unroll
        for (int d = 0; d < 64; ++d) q[d] = bf2f(PROJ[m * LDP + PC_QS + h * 64 + d]);
    } else {
#pragma unroll
        for (int d = 0; d < 128; ++d) q[d] = bf2f(PROJ[m * LDP + PC_QX + h * 128 + d]);
    }
    float o[DV];
#pragma unroll
    for (int d = 0; d < DV; ++d) o[d] = 0.f;
    float mx = -1e30f, l = 0.f;
    const int kbeg = MODE == 0 ? 0 : (MODE == 1 ? (q0 >= 128 ? q0 - 128 : 0) : 0), kend = MODE == 2 ? MEML : q0 + 128;
    for (int kt = kbeg; kt < kend; kt += 32) {
        __syncthreads();
        for (int idx = tid; idx < 32 * DQK; idx += 128) { const int j = idx / DQK, d = idx % DQK; float v;
            if constexpr (MODE == 0) { const size_t kr = (size_t)b * SEQ + kt + j; v = d < 64 ? bf2f(KVMLA[kr * 1024 + h * 128 + d]) : bf2f(PROJ[kr * LDP + PC_KR + (d - 64)]); }
            else if constexpr (MODE == 1) { const size_t kr = (size_t)b * SEQ + kt + j; v = bf2f(PROJ[kr * LDP + PC_KS + (h >> 2) * 64 + d]); }
            else { const size_t kr = (size_t)b * MEML + kt + j; v = bf2f(KVMEM[kr * 1024 + h * 128 + d]); }
            Ks[idx] = v; }
        for (int idx = tid; idx < 32 * DV; idx += 128) { const int j = idx / DV, d = idx % DV; float v;
            if constexpr (MODE == 0) { const size_t kr = (size_t)b * SEQ + kt + j; v = bf2f(KVMLA[kr * 1024 + h * 128 + 64 + d]); }
            else if constexpr (MODE == 1) { const size_t kr = (size_t)b * SEQ + kt + j; v = bf2f(PROJ[kr * LDP + PC_VS + (h >> 2) * 64 + d]); }
            else { const size_t kr = (size_t)b * MEML + kt + j; v = bf2f(KVMEM[kr * 1024 + 512 + h * 128 + vh * 64 + d]); }
            Vs[idx] = v; }
        __syncthreads();
        for (int j = 0; j < 32; ++j) {
            const int key = kt + j;
            bool ok = true; if (MODE == 0) ok = key <= qi; if (MODE == 1) ok = key <= qi && key >= qi - 127;
            if (!ok) continue;
            float s = 0.f;
#pragma unroll
            for (int d = 0; d < DQK; ++d) s += q[d] * Ks[j * DQK + d];
            if (s > mx) { const float al = exp2f(mx - s); l *= al;
#pragma unroll
                for (int d = 0; d < DV; ++d) o[d] *= al;
                mx = s; }
            const float p = exp2f(s - mx); l += p;
#pragma unroll
            for (int d = 0; d < DV; ++d) o[d] += p * Vs[j * DV + d];
        }
    }
    if constexpr (MODE == 1) { const float sl = a.sinks[h] * LOG2E; if (sl > mx) { const float al = exp2f(mx - sl); l *= al;
#pragma unroll
            for (int d = 0; d < DV; ++d) o[d] *= al;
            mx = sl; }
        l += exp2f(sl - mx); }
    const float rl = 1.f / l;
    bf16* O = (bf16*)(ws + WS_ATT) + m * 1536 + (MODE == 0 ? h * 64 : (MODE == 1 ? 512 + h * 64 : 1024 + h * 128 + vh * 64));
#pragma unroll
    for (int d = 0; d < DV; ++d) O[d] = (bf16)f2bf(o[d] * rl);
}

static void launch_fwd(const Args& base, int lo, int hi, int grid, hipStream_t stream) {
    Args a = base; a.ph_lo = lo; a.ph_hi = hi;
    hipLaunchKernelGGL(fwd, dim3(grid), dim3(NWAVES * 64), LDS_BYTES, stream, a);
}
extern "C" void kernel_launch(void* const* d_in, const int* in_sizes, int n_in, void* d_out, int out_size, void* d_ws, size_t ws_size, hipStream_t stream) {
    static int grid = 0;
    if (grid == 0) {
        if (n_in != 25 || in_sizes[0] != M * D || out_size != M * D || ws_size < WS_END) { fprintf(stderr, "kernel_launch: unexpected shapes (n_in %d, ws %zu)\n", n_in, ws_size); grid = -1; return; }
        int dev = 0, cus = 0;
        if (hipGetDevice(&dev) != hipSuccess || hipDeviceGetAttribute(&cus, hipDeviceAttributeMultiprocessorCount, dev) != hipSuccess) { grid = -1; return; }
        if (hipFuncSetAttribute((const void*)fwd, hipFuncAttributeMaxDynamicSharedMemorySize, LDS_BYTES) != hipSuccess) { fprintf(stderr, "kernel_launch: hipFuncSetAttribute failed\n"); grid = -1; return; }
        int per_cu = 0;
        if (hipOccupancyMaxActiveBlocksPerMultiprocessor(&per_cu, (const void*)fwd, NWAVES * 64, LDS_BYTES) != hipSuccess || per_cu < 1) fprintf(stderr, "kernel_launch: occupancy query says %d\n", per_cu);
        (void)hipGetLastError();
        grid = cus;
    }
    if (grid < 0) return;
    (void)hipMemsetAsync((char*)d_ws + WS_CTL, 0, CTL_ZERO_BYTES, stream);
    Args a{};
    a.x = (const float*)d_in[0]; a.mem = (const float*)d_in[1]; a.pos = (const int*)d_in[2];
    a.g_mix = (const float*)d_in[3]; a.w_in = (const float*)d_in[4]; a.g_mla_q = (const float*)d_in[5]; a.w_uq = (const float*)d_in[6]; a.g_mla_kv = (const float*)d_in[7];
    a.w_ukv = (const float*)d_in[8]; a.w_mla_o = (const float*)d_in[9]; a.sinks = (const float*)d_in[10]; a.w_swa_o = (const float*)d_in[11]; a.g_mem = (const float*)d_in[12];
    a.w_mem_kv = (const float*)d_in[13]; a.w_xa_o = (const float*)d_in[14]; a.b_gate = (const float*)d_in[15]; a.w_out = (const float*)d_in[16]; a.g_ffn = (const float*)d_in[17];
    a.w_router = (const float*)d_in[18]; a.b_router = (const float*)d_in[19]; a.w_gu = (const float*)d_in[20]; a.b_gu = (const float*)d_in[21]; a.w_dn = (const float*)d_in[22];
    a.b_dn = (const float*)d_in[23]; a.g_final = (const float*)d_in[24];
    a.out = (float*)d_out; a.ws = (unsigned char*)d_ws;
    constexpr unsigned INK = FAST_MASK | 0x985u;
    int p = 0;
    while (p < 12) {
        if (INK & (1u << p)) {
            int q = p + 1;
            if (ONE_LAUNCH) while (q < 12 && (INK & (1u << q))) ++q;
            launch_fwd(a, p, q, grid, stream); p = q; continue;
        }
        switch (p) {
            case 1: hipLaunchKernelGGL(nv_gemm<NV_PROJ>, dim3(75, M / 64), dim3(256), 0, stream, a);
                    hipLaunchKernelGGL(nv_gemm<NV_KVMEM>, dim3(16, MROWS / 64), dim3(256), 0, stream, a); break;
            case 3: hipLaunchKernelGGL(nv_gemm<NV_QMLA>, dim3(12, M / 64), dim3(256), 0, stream, a);
                    hipLaunchKernelGGL(nv_gemm<NV_KVMLA>, dim3(16, M / 64), dim3(256), 0, stream, a); break;
            case 4: hipLaunchKernelGGL(nv_attn<0>, dim3(SEQ / 128, 8, BATCH), dim3(128), 0, stream, a);
                    hipLaunchKernelGGL(nv_attn<1>, dim3(SEQ / 128, 8, BATCH), dim3(128), 0, stream, a);
                    hipLaunchKernelGGL(nv_attn<2>, dim3(SEQ / 128, 8, BATCH), dim3(128), 0, stream, a); break;
            case 5: hipLaunchKernelGGL(nv_gemm<NV_OUT3>, dim3(16, M / 64), dim3(256), 0, stream, a); break;
            case 6: hipLaunchKernelGGL(nv_gemm<NV_WOUT>, dim3(16, M / 64), dim3(256), 0, stream, a); break;
            case 9: hipLaunchKernelGGL(nv_gemm<NV_GU>, dim3(16, RMAX / 64), dim3(256), 0, stream, a); break;
            case 10: hipLaunchKernelGGL(nv_gemm<NV_DN>, dim3(16, RMAX / 64), dim3(256), 0, stream, a); break;
            default: break;
        }
        ++p;
    }
}
```

```cpp
#include <hip/hip_runtime.h>
#include <cstdio>
#include <cstdint>

#ifndef DUP_MASK
#define DUP_MASK 0u
#endif
#ifndef PROBE_SEL
#define PROBE_SEL (-1)
#endif
#ifndef PROBE_DIV
#define PROBE_DIV 10000.f
#endif
#ifndef ONE_LAUNCH
#define ONE_LAUNCH 1
#endif

#define GAS __attribute__((address_space(1)))
#define LAS __attribute__((address_space(3)))
typedef unsigned short bf16;
typedef unsigned v4u __attribute__((ext_vector_type(4)));
typedef unsigned v2u __attribute__((ext_vector_type(2)));
typedef float f32x4 __attribute__((ext_vector_type(4)));
typedef short bf16x8 __attribute__((ext_vector_type(8)));
typedef GAS unsigned gu32;

constexpr int BATCH = 2, SEQ = 8192, M = BATCH * SEQ, D = 1024, MEML = 256, MROWS = BATCH * MEML;
constexpr int NPSRC = 4768;
constexpr int LDP = 4864;
constexpr int PC_CQ = 0, PC_CKV = 256, PC_KR = 384, PC_QS = 512, PC_KS = 1024, PC_VS = 1152, PC_QX = 1280, PC_G = 1792;
constexpr int SC_QX = 1184, SC_G = 1696;
constexpr int NE = 32, TOPK = 4, DE = 1024;
constexpr int RMAX = 73728;
constexpr int NCHUNK = M / 64;
constexpr float EPS = 1e-6f;
constexpr float LOG2E = 1.4426950408889634f;
constexpr float C_MLA = LOG2E * 0.10206207261596577f;
constexpr float C_SWA = LOG2E * 0.125f;
constexpr float C_XA = LOG2E * 0.08838834764831845f;

constexpr size_t MiB = 1u << 20;
constexpr size_t WS_CTL = 0, CTL_ZERO_BYTES = 1 * MiB;
constexpr size_t WS_WIN = 2 * MiB;
constexpr size_t WS_WUQ = 12 * MiB;
constexpr size_t WS_WUKV = 12 * MiB + 512 * 1024;
constexpr size_t WS_WMKV = 13 * MiB;
constexpr size_t WS_WO3 = 15 * MiB;
constexpr size_t WS_WOUT = 18 * MiB;
constexpr size_t WS_RMLA = 20 * MiB;
constexpr size_t WS_RSWA = 22 * MiB;
constexpr size_t WS_MEMN = 26 * MiB;
constexpr size_t WS_KVMEM = 27 * MiB;
constexpr size_t WS_TKE = 28 * MiB;
constexpr size_t WS_TKW = 28 * MiB + 256 * 1024;
constexpr size_t WS_TKR = 28 * MiB + 512 * 1024;
constexpr size_t WS_LRK = 28 * MiB + 768 * 1024;
constexpr size_t WS_ROWW = 29 * MiB;
constexpr size_t WS_CNT = 30 * MiB;
constexpr size_t WS_TILE = 30 * MiB + 64 * 1024;
constexpr size_t WS_SSQQ = 31 * MiB;
constexpr size_t WS_SSQKV = 31 * MiB + 256 * 1024;
constexpr size_t WS_WGU = 32 * MiB;
constexpr size_t WS_WDN = 160 * MiB;
constexpr size_t WS_XN = 224 * MiB;
constexpr size_t WS_H = 256 * MiB;
constexpr size_t WS_PROJ = 320 * MiB;
constexpr size_t WS_QMLA = 472 * MiB;
constexpr size_t WS_KVMLA = 496 * MiB;
constexpr size_t WS_ATT = 528 * MiB;
constexpr size_t WS_MERGED = 576 * MiB;
constexpr size_t WS_MERGEDB = 640 * MiB;
constexpr size_t WS_HDN = 472 * MiB;
constexpr size_t WS_TOK = 672 * MiB;
constexpr size_t WS_TOKW = 674 * MiB;
constexpr size_t WS_END = 676 * MiB;
constexpr int CW_TMO = 0, CW_CODE = 1, CW_BAR = 4096, CW_ECNT = 65536;

constexpr int RING_BYTES = 131072;
constexpr int LDSCTL_OFF = RING_BYTES, MISC_OFF = LDSCTL_OFF + 320;
constexpr int SMALL_OFF = LDSCTL_OFF + 1024;
constexpr int LDS_BYTES = 147456;
constexpr int NWAVES = 8;

struct Args {
    const float *x, *mem; const int* pos;
    const float *g_mix, *w_in, *g_mla_q, *w_uq, *g_mla_kv, *w_ukv, *w_mla_o, *sinks, *w_swa_o, *g_mem, *w_mem_kv, *w_xa_o, *b_gate, *w_out, *g_ffn,
        *w_router, *b_router, *w_gu, *b_gu, *w_dn, *b_dn, *g_final;
    float* out; unsigned char* ws; int ph_lo, ph_hi;
};

#define RLX_AGENT __ATOMIC_RELAXED, __HIP_MEMORY_SCOPE_AGENT
#define LDS_WAIT() asm volatile("s_waitcnt lgkmcnt(0)" ::: "memory")
#define VM_WAIT() asm volatile("s_waitcnt vmcnt(0)" ::: "memory")
__device__ __forceinline__ unsigned f2bf(float f) { unsigned u = __builtin_bit_cast(unsigned, f); return (u + 0x7fffu + ((u >> 16) & 1u)) >> 16; }
__device__ __forceinline__ unsigned pk2(float lo, float hi) { return f2bf(lo) | (f2bf(hi) << 16); }
__device__ __forceinline__ float bf2f(unsigned v) { return __builtin_bit_cast(float, v << 16); }
__device__ __forceinline__ float bflo(unsigned w) { return __builtin_bit_cast(float, w << 16); }
__device__ __forceinline__ float bfhi(unsigned w) { return __builtin_bit_cast(float, w & 0xffff0000u); }
__device__ __forceinline__ float wave_sum(float v) {
#pragma unroll
    for (int o = 1; o < 64; o <<= 1) v += __shfl_xor(v, o);
    return v;
}

#define XB_TMO      128
#define XB_XCNT(j)  (256  + 64 * (j))
#define XB_XSUB(j)  (1280 + 64 * (j))
#define XB_XGEN(j)  (2304 + 64 * (j))
#define XB_TOP      3328
#define XB_TOPGEN   3392
#define XCD_BAR_WORDS 3456
#define XB_SPIN_CAP (1u << 18)
__device__ __forceinline__ unsigned xb_ld(unsigned* p)              { return __hip_atomic_load(p, __ATOMIC_RELAXED, __HIP_MEMORY_SCOPE_AGENT); }
__device__ __forceinline__ unsigned xb_add(unsigned* p, unsigned v) { return __hip_atomic_fetch_add(p, v, __ATOMIC_RELAXED, __HIP_MEMORY_SCOPE_AGENT); }
__device__ __forceinline__ unsigned xb_xcc_id() { return (unsigned)__builtin_amdgcn_s_getreg((3 << 11) | 20) & 0xFu; }
#define XB_SPIN(cond, bar) do { unsigned _sp = 0; while (cond) { __builtin_amdgcn_s_sleep(1); \
    if ((++_sp & 255u) == 0u) { if (xb_ld(&(bar)[XB_TMO])) break; if (_sp > XB_SPIN_CAP) { atomicAdd(&(bar)[XB_TMO], 1u); break; } } } } while (0)
struct XcdBarrier { unsigned* bar; unsigned x; volatile LAS unsigned* st; };
__device__ __forceinline__ XcdBarrier xcd_barrier_post(unsigned* bar, volatile LAS unsigned* st) {
    XcdBarrier b; b.bar = bar; b.x = xb_xcc_id(); b.st = st;
    if (threadIdx.x == 0) (void)xb_add(&bar[XB_XCNT(b.x)], 1u);
    return b;
}
__device__ __forceinline__ void xcd_barrier_complete(unsigned* bar, unsigned x, unsigned& nloc, unsigned& nx) {
    const unsigned G = gridDim.x * gridDim.y * gridDim.z;
    unsigned sum, cnt, mine, sp = 0u;
    for (;;) {
        sum = 0u; cnt = 0u; mine = 0u;
#pragma unroll
        for (unsigned j = 0; j < 16; ++j) { const unsigned c = xb_ld(&bar[XB_XCNT(j)]); sum += c; cnt += (c > 0u) ? 1u : 0u; mine = (j == x) ? c : mine; }
        if (sum == G) break;
        __builtin_amdgcn_s_sleep(1);
        if ((++sp & 255u) == 0u) { if (xb_ld(&bar[XB_TMO])) break; if (sp > XB_SPIN_CAP) { atomicAdd(&bar[XB_TMO], 1u); break; } }
    }
    nloc = mine > 0u ? mine : 1u; nx = cnt > 0u ? cnt : 1u;
}
__device__ __forceinline__ void xcd_barrier(const XcdBarrier& b) {
    asm volatile("s_waitcnt vmcnt(0)" ::: "memory");
    __syncthreads();
    if (threadIdx.x == 0) {
        unsigned* bar = b.bar;
        __builtin_amdgcn_s_waitcnt(0);
        unsigned nloc = b.st[0], nx = b.st[1];
        if (nloc == 0u) { xcd_barrier_complete(bar, b.x, nloc, nx); b.st[0] = nloc; b.st[1] = nx; }
        const unsigned old = xb_add(&bar[XB_XSUB(b.x)], 1u);
        const unsigned gen = old / nloc;
        if (old + 1u == (gen + 1u) * nloc) {
            __builtin_amdgcn_fence(__ATOMIC_RELEASE, "agent");
            asm volatile("s_waitcnt vmcnt(0)" ::: "memory");
            const unsigned og = xb_add(&bar[XB_TOP], 1u);
            const unsigned tg = og / nx;
            if (og + 1u == (tg + 1u) * nx) xb_add(&bar[XB_TOPGEN], 1u);
            else XB_SPIN(xb_ld(&bar[XB_TOPGEN]) == tg, bar);
            __builtin_amdgcn_fence(__ATOMIC_ACQUIRE, "agent");
            xb_add(&bar[XB_XGEN(b.x)], 1u);
            asm volatile("s_waitcnt vmcnt(0)" ::: "memory");
        } else {
            XB_SPIN(xb_ld(&bar[XB_XGEN(b.x)]) == gen, bar);
            __builtin_amdgcn_fence(__ATOMIC_ACQUIRE, "agent");
            asm volatile("s_waitcnt vmcnt(0)" ::: "memory");
        }
    }
    __syncthreads();
}

#ifndef BAR_FLAT
#define BAR_FLAT 0
#endif
__device__ __forceinline__ void flat_barrier(unsigned* bar, unsigned& epoch) {
    asm volatile("s_waitcnt vmcnt(0)" ::: "memory");
    __syncthreads();
    if (threadIdx.x == 0) {
        const unsigned G = gridDim.x;
        __builtin_amdgcn_fence(__ATOMIC_RELEASE, "agent");
        asm volatile("s_waitcnt vmcnt(0)" ::: "memory");
        (void)xb_add(&bar[XB_TOP], 1u);
        const unsigned target = (epoch + 1u) * G;
        XB_SPIN(xb_ld(&bar[XB_TOP]) < target, bar);
        __builtin_amdgcn_fence(__ATOMIC_ACQUIRE, "agent");
        asm volatile("s_waitcnt vmcnt(0)" ::: "memory");
    }
    __syncthreads();
    ++epoch;
}
namespace pg8 {
#define PG8_LAS __attribute__((address_space(3)))
typedef unsigned short bf16_t;
typedef short bf16x8 __attribute__((ext_vector_type(8)));
typedef float f32x4 __attribute__((ext_vector_type(4)));
typedef unsigned u32x4 __attribute__((ext_vector_type(4)));
constexpr int BM = 256, BK = 64, HALF = 128, HTB = HALF * BK * 2  , STAGE_BYTES = 8 * HTB, NXCD = 8, WGM = 8;

__host__ __device__ __forceinline__ int lds_byte(int r, int c) { const int st = (r >> 4) * 2 + (c >> 5), rr = r & 15, cc = c & 31, ob = rr * 64 + cc * 2; return st * 1024 + (ob ^ (((ob >> 9) & 1) << 5)); }
__host__ __device__ __forceinline__ void stage_rc(int b, int& R, int& C) { const int st = b / 1024, sb = b % 1024, swz = sb ^ (((sb >> 9) & 1) << 5); R = (st >> 1) * 16 + swz / 64; C = (st & 1) * 32 + (swz % 64) / 2; }
__host__ __device__ __forceinline__ int perm32(int rho) { const int n = rho >> 4, i = rho & 15; return 8 * (i >> 2) + 4 * n + (i & 3); }

struct Unit { int pm, pn, ka; };
struct Gemm { const bf16_t* A; const bf16_t* Bt; int M, N, K, lda, ldb; };

__device__ __forceinline__ unsigned cvt_pk_bf16(float lo, float hi) { unsigned r; asm volatile("v_cvt_pk_bf16_f32 %0, %1, %2" : "=v"(r) : "v"(lo), "v"(hi)); return r; }
typedef float f32x2 __attribute__((ext_vector_type(2)));
template <class Epi, class Sched, bool ALIGN_EPI = false, bool SP2 = false, bool GATHER = false>
__device__ __forceinline__ void gemm_phase(PG8_LAS unsigned char* lds, const Gemm g, const Sched& S, const Epi& E) {
    int tid_ = threadIdx.x; asm volatile("" : "+v"(tid_));
    const int tid = tid_, wid = __builtin_amdgcn_readfirstlane(tid >> 6), lane = tid & 63, wr = wid >> 2, wc = wid & 3, fr = lane & 15, fq = lane >> 4;
    int K_ = g.K; asm volatile("" : "+s"(K_));
    const int K = K_, nt = K / BK;
    unsigned voffA[2], voffB[2];
#pragma unroll
    for (int i = 0; i < 2; ++i) { int R, C; stage_rc(tid * 16 + i * 8192, R, C); const int Rb = Epi::PERM ? ((R & ~31) + perm32(R & 31)) : R;
        voffA[i] = (unsigned)(R * g.lda + C) * 2u; voffB[i] = (unsigned)(Rb * g.ldb + C) * 2u; }
    const size_t kstep = (size_t)(BK * 2);
    const size_t hstepA = (size_t)HALF * g.lda * 2, hstepB = (size_t)HALF * g.ldb * 2;
    const size_t tstepA = 2 * hstepA, tstepB = 2 * hstepB;
    const unsigned ldsw = (unsigned)wid * 1024u;
    const int aoff = lds_byte(wr * 64 + fr, fq * 8), boff = lds_byte(wc * 32 + fr, fq * 8);
#define PG8_SA(b, h) (((b) * 2 + (h)) * HTB)
#define PG8_SB(b, h) ((4 + (b) * 2 + (h)) * HTB)
#define PG8_STAGE(bufoff, gbase, voff) do { _Pragma("unroll") for (int _i = 0; _i < 2; ++_i) \
        __builtin_amdgcn_global_load_lds((const unsigned*)((const char*)(gbase) + (voff)[_i]), (PG8_LAS unsigned*)(lds + (bufoff) + ldsw + _i * 8192), 16, 0, 0); } while (0)
#define PG8_STAGEA(b_, h_, base_, nx_) do { if constexpr (GATHER) { const unsigned gv_[2] = {(nx_) ? gN[h_][0] : gA[h_][0], (nx_) ? gN[h_][1] : gA[h_][1]}; PG8_STAGE(PG8_SA(b_, h_), base_, gv_); } \
        else { PG8_STAGE(PG8_SA(b_, h_), (base_) + (h_) * hstepA, voffA); } } while (0)
#define PG8_GROWS(dst, un) do { _Pragma("unroll") for (int h_ = 0; h_ < 2; ++h_) _Pragma("unroll") for (int i_ = 0; i_ < 2; ++i_) { int R_, C_; stage_rc(tid * 16 + i_ * 8192, R_, C_); \
        dst[h_][i_] = (unsigned)S.row(un, h_ * HALF + R_) * (unsigned)(g.lda * 2) + (unsigned)(C_ * 2); } } while (0)
#define PG8_LDA(dst, b, h) do { _Pragma("unroll") for (int m = 0; m < 4; ++m) _Pragma("unroll") for (int k = 0; k < 2; ++k) dst[m][k] = *(const PG8_LAS bf16x8*)(lds + PG8_SA(b, h) + aoff + m * 2048 + k * 1024); } while (0)
#define PG8_LDB(dst, b, h) do { _Pragma("unroll") for (int n = 0; n < 2; ++n) _Pragma("unroll") for (int k = 0; k < 2; ++k) dst[n][k] = *(const PG8_LAS bf16x8*)(lds + PG8_SB(b, h) + boff + n * 2048 + k * 1024); } while (0)
#define PG8_MMA(ai, bj, At, Bt) do { __builtin_amdgcn_s_setprio(1); _Pragma("unroll") for (int m = 0; m < 4; ++m) _Pragma("unroll") for (int n = 0; n < 2; ++n) _Pragma("unroll") for (int k = 0; k < 2; ++k) \
        acc[ai][bj][m][n] = __builtin_amdgcn_mfma_f32_16x16x32_bf16(Bt[n][k], At[m][k], acc[ai][bj][m][n], 0, 0, 0); __builtin_amdgcn_s_setprio(0); } while (0)
#define PG8_WAIT_V(n) asm volatile("s_waitcnt vmcnt(" #n ")" ::: "memory")
#define PG8_WAIT_L(n) asm volatile("s_waitcnt lgkmcnt(" #n ")" ::: "memory")
#define PG8_BAR __builtin_amdgcn_s_barrier()
#define PG8_SCHED __builtin_amdgcn_sched_barrier(0)
    Unit cur, nxt; int ui = 0;
    if (!S.next(0, cur)) return;
    f32x4 acc[2][2][4][2];
#pragma unroll
    for (int a = 0; a < 2; ++a)
#pragma unroll
        for (int b = 0; b < 2; ++b)
#pragma unroll
            for (int m = 0; m < 4; ++m)
#pragma unroll
                for (int n = 0; n < 2; ++n) acc[a][b][m][n] = (f32x4){0.f, 0.f, 0.f, 0.f};
    bf16x8 At[4][2], B0[2][2], B1[2][2];
    const size_t tstepAe = GATHER ? 0 : tstepA;
    unsigned gA[2][2] = {{0u, 0u}, {0u, 0u}}, gN[2][2] = {{0u, 0u}, {0u, 0u}};
    if constexpr (GATHER) { PG8_GROWS(gA, cur); }
    const char* cA = (const char*)g.A + (size_t)cur.pm * tstepAe + (size_t)cur.ka * 2; const char* cB = (const char*)g.Bt + (size_t)cur.pn * tstepB;
    S.a_ready(cur);
    if constexpr (SP2) {
        PG8_STAGE(PG8_SB(0, 0), cB, voffB); PG8_STAGE(PG8_SB(0, 1), cB + hstepB, voffB); PG8_STAGEA(0, 0, cA, false); PG8_STAGEA(0, 1, cA, false);
        if (wr == 1) PG8_BAR;
        PG8_WAIT_V(2); PG8_BAR;
        PG8_STAGE(PG8_SB(1, 0), cB + kstep, voffB); PG8_STAGEA(1, 0, cA + kstep, false); PG8_STAGE(PG8_SB(1, 1), cB + hstepB + kstep, voffB);
        PG8_WAIT_V(6); PG8_BAR;
    } else {
        PG8_STAGE(PG8_SB(0, 0), cB, voffB); PG8_STAGEA(0, 0, cA, false); PG8_STAGE(PG8_SB(0, 1), cB + hstepB, voffB); PG8_STAGEA(0, 1, cA, false);
        if (wr == 1) PG8_BAR;
        PG8_WAIT_V(4); PG8_BAR;
        PG8_STAGE(PG8_SB(1, 0), cB + kstep, voffB); PG8_STAGEA(1, 0, cA + kstep, false); PG8_STAGE(PG8_SB(1, 1), cB + hstepB + kstep, voffB);
        PG8_WAIT_V(6); PG8_BAR;
    }
    for (;;) {
        const bool has_next = S.next(ui + 1, nxt);
        if constexpr (GATHER) { if (has_next) { PG8_GROWS(gN, nxt); } else { gN[0][0] = gA[0][0]; gN[0][1] = gA[0][1]; gN[1][0] = gA[1][0]; gN[1][1] = gA[1][1]; } }
        const char* nA = has_next ? (const char*)g.A + (size_t)nxt.pm * tstepAe + (size_t)nxt.ka * 2 : cA; const char* nB = has_next ? (const char*)g.Bt + (size_t)nxt.pn * tstepB : cB;
        for (int t = 0; t < nt; t += 2) {
            const bool last = (t == nt - 2);
            const char* a1 = cA + (size_t)(t + 1) * kstep;
            const char* a2 = last ? nA : cA + (size_t)(t + 2) * kstep; const char* b2 = last ? nB : cB + (size_t)(t + 2) * kstep;
            const char* a3 = a2 + kstep; const char* b3 = b2 + kstep;
            if (last && has_next) S.a_ready(nxt);
            if constexpr (SP2) {
            PG8_LDB(B0, 0, 0); PG8_LDB(B1, 0, 1); PG8_SCHED; PG8_LDA(At, 0, 0); PG8_STAGEA(1, 1, a1, false);
            PG8_WAIT_V(8); PG8_WAIT_L(0); PG8_BAR; PG8_MMA(0, 0, At, B0); PG8_MMA(0, 1, At, B1); PG8_BAR; PG8_SCHED;
            PG8_LDA(At, 0, 1); PG8_STAGE(PG8_SB(0, 0), b2, voffB); PG8_STAGE(PG8_SB(0, 1), b2 + hstepB, voffB); PG8_STAGEA(0, 0, a2, last);
            PG8_WAIT_V(8); PG8_WAIT_L(0); PG8_BAR; PG8_MMA(1, 0, At, B0); PG8_MMA(1, 1, At, B1); PG8_BAR; PG8_SCHED;
            PG8_LDB(B0, 1, 0); PG8_LDB(B1, 1, 1); PG8_SCHED; PG8_LDA(At, 1, 0); PG8_STAGEA(0, 1, a2, last);
            PG8_WAIT_V(8); PG8_WAIT_L(0); PG8_BAR; PG8_MMA(0, 0, At, B0); PG8_MMA(0, 1, At, B1); PG8_BAR; PG8_SCHED;
            PG8_LDA(At, 1, 1); PG8_STAGE(PG8_SB(1, 0), b3, voffB); PG8_STAGE(PG8_SB(1, 1), b3 + hstepB, voffB); PG8_STAGEA(1, 0, a3, last);
            PG8_WAIT_V(8); PG8_WAIT_L(0); PG8_BAR; PG8_MMA(1, 0, At, B0); PG8_MMA(1, 1, At, B1); PG8_BAR; PG8_SCHED;
            } else {
            PG8_LDB(B0, 0, 0); PG8_SCHED; PG8_LDA(At, 0, 0); PG8_STAGEA(1, 1, a1, false);
            PG8_WAIT_L(8); PG8_BAR; PG8_WAIT_L(0); PG8_MMA(0, 0, At, B0); PG8_BAR; PG8_SCHED;
            PG8_LDB(B1, 0, 1); PG8_STAGE(PG8_SB(0, 0), b2, voffB);
            PG8_BAR; PG8_WAIT_L(0); PG8_MMA(0, 1, At, B1); PG8_BAR;
            PG8_LDA(At, 0, 1); PG8_STAGEA(0, 0, a2, last);
            PG8_BAR; PG8_WAIT_L(0); PG8_MMA(1, 0, At, B0); PG8_BAR; PG8_SCHED;
            PG8_STAGE(PG8_SB(0, 1), b2 + hstepB, voffB);
            PG8_WAIT_V(6); PG8_BAR; PG8_MMA(1, 1, At, B1); PG8_BAR;
            PG8_LDB(B0, 1, 0); PG8_SCHED; PG8_LDA(At, 1, 0); PG8_STAGEA(0, 1, a2, last);
            PG8_WAIT_L(8); PG8_BAR; PG8_WAIT_L(0); PG8_MMA(0, 0, At, B0); PG8_BAR; PG8_SCHED;
            PG8_LDB(B1, 1, 1); PG8_STAGE(PG8_SB(1, 0), b3, voffB);
            PG8_BAR; PG8_WAIT_L(0); PG8_MMA(0, 1, At, B1); PG8_BAR;
            PG8_LDA(At, 1, 1); PG8_STAGEA(1, 0, a3, last);
            PG8_BAR; PG8_WAIT_L(0); PG8_MMA(1, 0, At, B0); PG8_BAR; PG8_SCHED;
            PG8_STAGE(PG8_SB(1, 1), b3 + hstepB, voffB);
            PG8_WAIT_V(6); PG8_BAR; PG8_MMA(1, 1, At, B1); PG8_BAR;
            }
        }
        if constexpr (ALIGN_EPI) { if (wr == 0) PG8_BAR; }
        if constexpr (!Epi::AFTER_DRAIN) { E(acc, cur, wr, wc, fr, fq); S.done(cur); }
        if (!has_next) break;
#pragma unroll
        for (int a = 0; a < 2; ++a)
#pragma unroll
            for (int b = 0; b < 2; ++b)
#pragma unroll
                for (int m = 0; m < 4; ++m)
#pragma unroll
                    for (int n = 0; n < 2; ++n) acc[a][b][m][n] = (f32x4){0.f, 0.f, 0.f, 0.f};
        cur = nxt; cA = nA; cB = nB; ++ui;
        if constexpr (GATHER) { gA[0][0] = gN[0][0]; gA[0][1] = gN[0][1]; gA[1][0] = gN[1][0]; gA[1][1] = gN[1][1]; }
        if constexpr (ALIGN_EPI) { if (wr == 1) PG8_BAR; }
    }
    PG8_WAIT_V(0);
    if constexpr (!ALIGN_EPI) { if (wr == 0) PG8_BAR; }
    PG8_BAR;
    if constexpr (Epi::AFTER_DRAIN) { E.fused(acc, cur, wr, wc, fr, fq, lds, wid, lane); S.done(cur); }
#undef PG8_SA
#undef PG8_SB
#undef PG8_STAGE
#undef PG8_STAGEA
#undef PG8_GROWS
#undef PG8_LDA
#undef PG8_LDB
#undef PG8_MMA
#undef PG8_WAIT_V
#undef PG8_WAIT_L
#undef PG8_BAR
#undef PG8_SCHED
}
struct StaticOrder {
    int nM, nN, nwg, G, c;
    __host__ __device__ void init(int M, int N, int G_, int c_) { nM = M / BM; nN = N / BM; nwg = nM * nN; G = G_; c = c_; }
    __host__ __device__ bool next(int i, Unit& u) const {
        const long L = (long)i * G + c; if (L >= nwg) return false;
        int wgid = (int)L; { const int q = nwg / NXCD, r = nwg % NXCD, xcd = wgid % NXCD, off = wgid / NXCD; wgid = (xcd < r ? xcd * (q + 1) : r * (q + 1) + (xcd - r) * q) + off; }
        const int nig = WGM * nN, gid = wgid / nig, fm = gid * WGM, gsz = (nM - fm) < WGM ? (nM - fm) : WGM;
        u.pm = fm + ((wgid % nig) % gsz); u.pn = (wgid % nig) / gsz; u.ka = 0; return true;
    }
    __device__ __forceinline__ void a_ready(const Unit&) const {}
    __device__ __forceinline__ void done(const Unit&) const {}
};
struct SimpleOrder {
    int nN, nwg, G, c;
    __device__ __forceinline__ bool next(int i, Unit& u) const { const int L = i * G + c; if (L >= nwg) return false; u.pm = L / nN; u.pn = L % nN; u.ka = 0; return true; }
    __device__ __forceinline__ void a_ready(const Unit&) const {}
    __device__ __forceinline__ void done(const Unit&) const {}
};
struct TailOrder {
    int nN, nwg, G, c;
    __device__ __forceinline__ bool next(int i, Unit& u) const { const int L = c - (G - nwg); if (i > 0 || L < 0 || L >= nwg) return false; u.pm = L / nN; u.pn = L % nN; u.ka = 0; return true; }
    __device__ __forceinline__ void a_ready(const Unit&) const {}
    __device__ __forceinline__ void done(const Unit&) const {}
};
struct Gate3Order {
    int G, c;
    __device__ __forceinline__ bool next(int i, Unit& u) const { const int t = (i / 3) * G + c, b = i % 3; if (t >= 256) return false; u.pm = t >> 2; u.pn = b * 4 + (t & 3); u.ka = b * 512; return true; }
    __device__ __forceinline__ void a_ready(const Unit&) const {}
    __device__ __forceinline__ void done(const Unit&) const {}
};
template <int NPN> struct MoeOrder {
    const PG8_LAS int* tb; const int* tok; int G, c;
    __device__ __forceinline__ bool next(int i, Unit& u) const { const int nt = __builtin_amdgcn_readfirstlane(tb[64]); const int L = i * G + c; if (L >= nt * NPN) return false;
        u.pm = L / NPN; const int e = __builtin_amdgcn_readfirstlane(tb[96 + u.pm]); u.pn = e * NPN + (L % NPN); u.ka = 0; return true; }
    __device__ __forceinline__ int row(const Unit& u, int r) const { const int e = u.pn / NPN, t0 = __builtin_amdgcn_readfirstlane(tb[32 + e]), n = __builtin_amdgcn_readfirstlane(tb[e]), pos = ((u.pm - t0) << 8) + r;
        return pos < n ? tok[e * 16384 + pos] : 0; }
    __device__ __forceinline__ void a_ready(const Unit&) const {}
    __device__ __forceinline__ void done(const Unit&) const {}
};
__device__ __forceinline__ u32x4 pack8(const f32x4 v0, const f32x4 v1) { u32x4 w; w.x = cvt_pk_bf16(v0[0], v0[1]); w.y = cvt_pk_bf16(v0[2], v0[3]); w.z = cvt_pk_bf16(v1[0], v1[1]); w.w = cvt_pk_bf16(v1[2], v1[3]); return w; }
__device__ __forceinline__ float sigm(float x) { return __builtin_amdgcn_rcpf(1.f + __expf(-x)); }
struct EpiPlain {
    static constexpr bool PERM = true, AFTER_DRAIN = false;
    bf16_t* O; int ldc; float scale;
    __device__ __forceinline__ void operator()(const f32x4 (&acc)[2][2][4][2], const Unit& u, int wr, int wc, int fr, int fq) const {
        const int row0 = u.pm * BM + wr * 64 + fr, col0 = u.pn * BM + wc * 32 + 8 * fq;
#pragma unroll
        for (int ai = 0; ai < 2; ++ai)
#pragma unroll
            for (int m = 0; m < 4; ++m) { bf16_t* rowp = O + (size_t)(row0 + ai * HALF + m * 16) * ldc + col0;
#pragma unroll
                for (int bj = 0; bj < 2; ++bj) *(u32x4*)(rowp + bj * HALF) = pack8(acc[ai][bj][m][0] * scale, acc[ai][bj][m][1] * scale); }
    }
};
__device__ __forceinline__ void rope8(f32x4& v0, f32x4& v1, const float* t, float sc) {
    const f32x4 t0 = *(const f32x4*)t, t1 = *(const f32x4*)(t + 4); f32x4 p, q;
    p[0] = (v0[0] * t0[0] - v0[1] * t0[1]) * sc; p[1] = (v0[1] * t0[0] + v0[0] * t0[1]) * sc; p[2] = (v0[2] * t0[2] - v0[3] * t0[3]) * sc; p[3] = (v0[3] * t0[2] + v0[2] * t0[3]) * sc;
    q[0] = (v1[0] * t1[0] - v1[1] * t1[1]) * sc; q[1] = (v1[1] * t1[0] + v1[0] * t1[1]) * sc; q[2] = (v1[2] * t1[2] - v1[3] * t1[3]) * sc; q[3] = (v1[3] * t1[2] + v1[2] * t1[3]) * sc;
    v0 = p; v1 = q;
}
struct EpiProj {
    static constexpr bool PERM = true, AFTER_DRAIN = false;
    bf16_t* O; const float* bgate; const float* rswa; const float* rmla; float* ssqq; float* ssqkv; float cxa, cswa;
    __device__ __forceinline__ void operator()(const f32x4 (&acc)[2][2][4][2], const Unit& u, int wr, int wc, int fr, int fq) const {
        const int pn = u.pn, row0 = u.pm * BM + wr * 64 + fr, col0 = pn * BM + wc * 32 + 8 * fq;
        const bool gate = pn >= 7; const float sc = (pn == 5 || pn == 6) ? cxa : 1.f;
        f32x4 bv[2][2];
#pragma unroll
        for (int bj = 0; bj < 2; ++bj)
#pragma unroll
            for (int n = 0; n < 2; ++n) bv[bj][n] = gate ? *(const f32x4*)(bgate + (col0 - 1792) + bj * HALF + 4 * n) : (f32x4){0.f, 0.f, 0.f, 0.f};
#pragma unroll
        for (int ai = 0; ai < 2; ++ai)
#pragma unroll
            for (int m = 0; m < 4; ++m) { const int row = row0 + ai * HALF + m * 16; bf16_t* rowp = O + (size_t)row * 4864 + col0;
#pragma unroll
                for (int bj = 0; bj < 2; ++bj) { f32x4 v0 = acc[ai][bj][m][0], v1 = acc[ai][bj][m][1];
                    if (gate) { v0 += bv[bj][0]; v1 += bv[bj][1];
#pragma unroll
                        for (int q = 0; q < 4; ++q) { v0[q] = sigm(v0[q]); v1[q] = sigm(v1[q]); } }
                    else if (pn == 2 || pn == 3 || (pn == 4 && bj == 0)) rope8(v0, v1, rswa + ((size_t)row * 32 + (((col0 + bj * HALF) & 63) >> 1)) * 2, pn == 4 ? 1.f : cswa);
                    else if (pn == 1 && bj == 1) { if (wc == 0) rope8(v0, v1, rmla + ((size_t)row * 16 + 4 * fq) * 2, 1.f); }
                    else { v0 = v0 * sc; v1 = v1 * sc; }
                    *(u32x4*)(rowp + bj * HALF) = pack8(v0, v1); }
                if (pn <= 1) {
                    float s = 0.f;
#pragma unroll
                    for (int n = 0; n < 2; ++n) { const f32x4 x = acc[ai][0][m][n]; s += (x[0] * x[0] + x[1] * x[1]) + (x[2] * x[2] + x[3] * x[3]); }
                    if (pn == 0) {
#pragma unroll
                        for (int n = 0; n < 2; ++n) { const f32x4 x = acc[ai][1][m][n]; s += (x[0] * x[0] + x[1] * x[1]) + (x[2] * x[2] + x[3] * x[3]); } }
                    s += __shfl_xor(s, 16); s += __shfl_xor(s, 32);
                    if (fq == 0) (pn == 0 ? ssqq : ssqkv)[(size_t)row * 4 + wc] = s; }
                asm volatile("" ::: "memory"); }
    }
};
struct EpiQmla {
    static constexpr bool PERM = true, AFTER_DRAIN = false;
    bf16_t* O; const float* ssq; const float* rmla; float scale;
    __device__ __forceinline__ void operator()(const f32x4 (&acc)[2][2][4][2], const Unit& u, int wr, int wc, int fr, int fq) const {
        const int row0 = u.pm * BM + wr * 64 + fr, col0 = u.pn * BM + wc * 32 + 8 * fq;
#pragma unroll
        for (int ai = 0; ai < 2; ++ai)
#pragma unroll
            for (int m = 0; m < 4; ++m) { const int row = row0 + ai * HALF + m * 16; const f32x4 pq = *(const f32x4*)(ssq + (size_t)row * 4);
                const float rs = rsqrtf(((pq[0] + pq[1]) + (pq[2] + pq[3])) * (1.f / 256.f) + 1e-6f) * scale;
#pragma unroll
                for (int bj = 0; bj < 2; ++bj) { const int col = col0 + bj * HALF, off = col % 96; f32x4 v0 = acc[ai][bj][m][0] * rs, v1 = acc[ai][bj][m][1] * rs;
                    if (off >= 64) rope8(v0, v1, rmla + ((size_t)row * 16 + ((off - 64) >> 1)) * 2, 1.f);
                    *(u32x4*)(O + (size_t)row * 768 + col) = pack8(v0, v1); }
                asm volatile("" ::: "memory"); }
    }
};
struct EpiRowScale {
    static constexpr bool PERM = true, AFTER_DRAIN = false;
    bf16_t* O; int ldc; const float* ssq; float invn;
    __device__ __forceinline__ void operator()(const f32x4 (&acc)[2][2][4][2], const Unit& u, int wr, int wc, int fr, int fq) const {
        const int row0 = u.pm * BM + wr * 64 + fr, col0 = u.pn * BM + wc * 32 + 8 * fq;
#pragma unroll
        for (int ai = 0; ai < 2; ++ai)
#pragma unroll
            for (int m = 0; m < 4; ++m) { const int row = row0 + ai * HALF + m * 16; const f32x4 pq = *(const f32x4*)(ssq + (size_t)row * 4);
                const float rs = rsqrtf(((pq[0] + pq[1]) + (pq[2] + pq[3])) * invn + 1e-6f);
#pragma unroll
                for (int bj = 0; bj < 2; ++bj) *(u32x4*)(O + (size_t)row * ldc + col0 + bj * HALF) = pack8(acc[ai][bj][m][0] * rs, acc[ai][bj][m][1] * rs);
                asm volatile("" ::: "memory"); }
    }
};
struct EpiGate3 {
    static constexpr bool PERM = true, AFTER_DRAIN = false;
    const bf16_t* P; float* Mg; bf16_t* Mb;
    __device__ __forceinline__ void operator()(const f32x4 (&acc)[2][2][4][2], const Unit& u, int wr, int wc, int fr, int fq) const {
        const int b = u.pn >> 2, row0 = u.pm * BM + wr * 64 + fr, col0 = (u.pn & 3) * BM + wc * 32 + 8 * fq;
#pragma unroll
        for (int ai = 0; ai < 2; ++ai)
#pragma unroll
            for (int m = 0; m < 4; ++m) { const size_t row = (size_t)(row0 + ai * HALF + m * 16);
#pragma unroll
                for (int bj = 0; bj < 2; ++bj) { const int col = col0 + bj * HALF;
                    const u32x4 gw = *(const u32x4*)(P + row * 4864 + 1792 + b * 1024 + col);
                    f32x4 g0, g1; g0[0] = __builtin_bit_cast(float, gw.x << 16); g0[1] = __builtin_bit_cast(float, gw.x & 0xffff0000u); g0[2] = __builtin_bit_cast(float, gw.y << 16); g0[3] = __builtin_bit_cast(float, gw.y & 0xffff0000u);
                    g1[0] = __builtin_bit_cast(float, gw.z << 16); g1[1] = __builtin_bit_cast(float, gw.z & 0xffff0000u); g1[2] = __builtin_bit_cast(float, gw.w << 16); g1[3] = __builtin_bit_cast(float, gw.w & 0xffff0000u);
                    f32x4 v0 = acc[ai][bj][m][0] * g0, v1 = acc[ai][bj][m][1] * g1;
                    float* mp = Mg + row * 1024 + col;
                    if (b > 0) { v0 += *(const f32x4*)mp; v1 += *(const f32x4*)(mp + 4); }
                    if (b < 2) { *(f32x4*)mp = v0; *(f32x4*)(mp + 4) = v1; }
                    else *(u32x4*)(Mb + row * 1024 + col) = pack8(v0, v1); } }
    }
};
struct EpiResF32 {
    static constexpr bool PERM = true, AFTER_DRAIN = false;
    const float* base; float* O;
    __device__ __forceinline__ void operator()(const f32x4 (&acc)[2][2][4][2], const Unit& u, int wr, int wc, int fr, int fq) const {
        const int row0 = u.pm * BM + wr * 64 + fr, col0 = u.pn * BM + wc * 32 + 8 * fq;
#pragma unroll
        for (int ai = 0; ai < 2; ++ai)
#pragma unroll
            for (int m = 0; m < 4; ++m) { const size_t off = (size_t)(row0 + ai * HALF + m * 16) * 1024 + col0;
#pragma unroll
                for (int bj = 0; bj < 2; ++bj) { const float* bp = base + off + bj * HALF; float* op = O + off + bj * HALF;
                    *(f32x4*)op = *(const f32x4*)bp + acc[ai][bj][m][0]; *(f32x4*)(op + 4) = *(const f32x4*)(bp + 4) + acc[ai][bj][m][1]; } }
    }
};
struct EpiSwiglu {
    static constexpr bool PERM = true, AFTER_DRAIN = false;
    bf16_t* O; const float* bgu;
    __device__ __forceinline__ void operator()(const f32x4 (&acc)[2][2][4][2], const Unit& u, int wr, int wc, int fr, int fq) const {
        const int e = u.pn >> 3, row0 = u.pm * BM + wr * 64 + fr, col0 = (u.pn & 7) * HALF + wc * 32 + 8 * fq;
        const float* bp = bgu + (size_t)e * 2048 + col0;
        const f32x4 bg0 = *(const f32x4*)bp, bg1 = *(const f32x4*)(bp + 4), bl0 = *(const f32x4*)(bp + 1024), bl1 = *(const f32x4*)(bp + 1028);
#pragma unroll
        for (int ai = 0; ai < 2; ++ai)
#pragma unroll
            for (int m = 0; m < 4; ++m) { f32x4 g0 = acc[ai][0][m][0] + bg0, g1 = acc[ai][0][m][1] + bg1, l0 = acc[ai][1][m][0] + bl0, l1 = acc[ai][1][m][1] + bl1, h0, h1;
#pragma unroll
                for (int q = 0; q < 4; ++q) { float g = fminf(g0[q], 7.f), l = fminf(fmaxf(l0[q], -7.f), 7.f); h0[q] = g * sigm(1.702f * g) * (l + 1.f);
                    g = fminf(g1[q], 7.f); l = fminf(fmaxf(l1[q], -7.f), 7.f); h1[q] = g * sigm(1.702f * g) * (l + 1.f); }
                *(u32x4*)(O + (size_t)(row0 + ai * HALF + m * 16) * 1024 + col0) = pack8(h0, h1); }
    }
};
struct EpiDown {
    static constexpr bool PERM = true, AFTER_DRAIN = false;
    bf16_t* O; const float* bdn; const float* tokw; const PG8_LAS int* tb;
    __device__ __forceinline__ void operator()(const f32x4 (&acc)[2][2][4][2], const Unit& u, int wr, int wc, int fr, int fq) const {
        const int e = u.pn >> 2, row0 = u.pm * BM + wr * 64 + fr, col0 = (u.pn & 3) * BM + wc * 32 + 8 * fq;
        const float* roww = tokw + (size_t)e * 16384 - ((size_t)__builtin_amdgcn_readfirstlane(tb[32 + e]) << 8);
        f32x4 bv[2][2];
#pragma unroll
        for (int bj = 0; bj < 2; ++bj)
#pragma unroll
            for (int n = 0; n < 2; ++n) bv[bj][n] = *(const f32x4*)(bdn + (size_t)e * 1024 + col0 + bj * HALF + 4 * n);
#pragma unroll
        for (int ai = 0; ai < 2; ++ai)
#pragma unroll
            for (int m = 0; m < 4; ++m) { const int row = row0 + ai * HALF + m * 16; const float w = roww[row]; bf16_t* rowp = O + (size_t)row * 1024 + col0;
#pragma unroll
                for (int bj = 0; bj < 2; ++bj) *(u32x4*)(rowp + bj * HALF) = pack8((acc[ai][bj][m][0] + bv[bj][0]) * w, (acc[ai][bj][m][1] + bv[bj][1]) * w); }
    }
};
}

struct Frame {
    LAS unsigned char* lds;
    volatile LAS unsigned* MISC;
    gu32* ctl;
    int tid, lane, wave, vcu, G;
    unsigned char* ws;
};
#define WSP(T, off) ((T*)(F.ws + (off)))

__device__ __forceinline__ void rms_row_to_bf16(const float* xrow, const float* g, bf16* orow, int lane) {
    const GAS f32x4* xr = (const GAS f32x4*)xrow + lane; const GAS f32x4* gr = (const GAS f32x4*)g + lane;
    f32x4 v[4]; float s = 0.f;
#pragma unroll
    for (int j = 0; j < 4; ++j) { v[j] = xr[64 * j]; s += (v[j].x * v[j].x + v[j].y * v[j].y) + (v[j].z * v[j].z + v[j].w * v[j].w); }
    const float rstd = 1.f / sqrtf(wave_sum(s) * (1.f / D) + EPS);
    GAS unsigned long long* o8 = (GAS unsigned long long*)orow + lane;
#pragma unroll
    for (int j = 0; j < 4; ++j) { const f32x4 gg = gr[64 * j];
        o8[64 * j] = (unsigned long long)pk2(v[j].x * rstd * gg.x, v[j].y * rstd * gg.y) | ((unsigned long long)pk2(v[j].z * rstd * gg.z, v[j].w * rstd * gg.w) << 32); }
}
struct TItem { const float* W; const float* gain; bf16* WT; int ldw, K, k0, dst_row0, srccol; };
__device__ __forceinline__ int perm_pair(int p, int half) { return (p & 1) ? half + (p >> 1) : (p >> 1); }
constexpr int I_IN = 16 * 152, I_UQ = 4 * 24, I_UKV = 2 * 32, I_MKV = 16 * 32, I_O = 8 * 32, I_OUT = 16 * 32, I_GU = 16 * 64, I_DN = 16 * 32;
constexpr int NITEMS = I_IN + I_UQ + I_UKV + I_MKV + 3 * I_O + I_OUT + NE * I_GU + NE * I_DN;
__device__ __forceinline__ TItem p0_decode(const Args& a, unsigned char* wsb, int it, int lane) {
    TItem t; t.gain = nullptr; const int ln = lane & 31; int r = it;
    if (r < I_IN) { const int kb = r / 152, nb = r % 152, n = nb * 32 + ln; int src;
        if (n < 384) src = n; else if (n < 416) src = 384 + perm_pair(n - 384, 16); else if (n < 512) src = -1;
        else if (n < 1152) { const int j = n - 512; src = 416 + (j & ~63) + perm_pair(j & 63, 32); }
        else src = n - 96;
        t.W = a.w_in; t.WT = (bf16*)(wsb + WS_WIN); t.ldw = NPSRC; t.K = 1024; t.k0 = kb * 64; t.dst_row0 = nb * 32; t.srccol = src; return t; } r -= I_IN;
    if (r < I_UQ) { const int kb = r / 24, nb = r % 24, n = nb * 32 + ln, hh = n / 96, off = n % 96;
        t.W = a.w_uq; t.gain = a.g_mla_q; t.WT = (bf16*)(wsb + WS_WUQ); t.ldw = 768; t.K = 256; t.k0 = kb * 64; t.dst_row0 = nb * 32; t.srccol = off < 64 ? n : hh * 96 + 64 + perm_pair(off - 64, 16); return t; } r -= I_UQ;
    if (r < I_UKV) { const int kb = r / 32, nb = r % 32;
        t.W = a.w_ukv; t.gain = a.g_mla_kv; t.WT = (bf16*)(wsb + WS_WUKV); t.ldw = 1024; t.K = 128; t.k0 = kb * 64; t.dst_row0 = nb * 32; t.srccol = nb * 32 + ln; return t; } r -= I_UKV;
    if (r < I_MKV) { const int kb = r / 32, nb = r % 32;
        t.W = a.w_mem_kv; t.WT = (bf16*)(wsb + WS_WMKV); t.ldw = 1024; t.K = 1024; t.k0 = kb * 64; t.dst_row0 = nb * 32; t.srccol = nb * 32 + ln; return t; } r -= I_MKV;
    if (r < 3 * I_O) { const int b = r / I_O, q = r % I_O, kb = q / 32, nb = q % 32;
        t.W = b == 0 ? a.w_mla_o : (b == 1 ? a.w_swa_o : a.w_xa_o); t.WT = (bf16*)(wsb + WS_WO3); t.ldw = 1024; t.K = 512; t.k0 = kb * 64; t.dst_row0 = b * 1024 + nb * 32; t.srccol = nb * 32 + ln; return t; } r -= 3 * I_O;
    if (r < I_OUT) { const int kb = r / 32, nb = r % 32;
        t.W = a.w_out; t.WT = (bf16*)(wsb + WS_WOUT); t.ldw = 1024; t.K = 1024; t.k0 = kb * 64; t.dst_row0 = nb * 32; t.srccol = nb * 32 + ln; return t; } r -= I_OUT;
    if (r < NE * I_GU) { const int e = r / I_GU, q = r % I_GU, kb = q / 64, nb = q % 64, n = nb * 32 + ln, pn = n >> 8, j = n & 255;
        t.W = a.w_gu + (size_t)e * 1024 * 2048; t.WT = (bf16*)(wsb + WS_WGU); t.ldw = 2048; t.K = 1024; t.k0 = kb * 64; t.dst_row0 = e * 2048 + nb * 32;
        t.srccol = j < 128 ? 128 * pn + j : 1024 + 128 * pn + (j - 128); return t; } r -= NE * I_GU;
    { const int e = r / I_DN, q = r % I_DN, kb = q / 32, nb = q % 32;
      t.W = a.w_dn + (size_t)e * 1024 * 1024; t.WT = (bf16*)(wsb + WS_WDN); t.ldw = 1024; t.K = 1024; t.k0 = kb * 64; t.dst_row0 = e * 1024 + nb * 32; t.srccol = nb * 32 + ln; return t; }
}
__device__ __forceinline__ void p0_load(const TItem& t, float (&x)[32], int lane) {
    const int kh = lane >> 5;
    if (t.srccol < 0) {
#pragma unroll
        for (int i = 0; i < 32; ++i) x[i] = 0.f;
    } else {
        const float* p = t.W + (size_t)(t.k0 + kh) * t.ldw + t.srccol;
#pragma unroll
        for (int i = 0; i < 32; ++i) x[i] = p[(size_t)(2 * i) * t.ldw];
        if (t.gain) {
#pragma unroll
            for (int i = 0; i < 32; ++i) x[i] *= t.gain[t.k0 + 2 * i + kh];
        }
    }
}
__device__ __forceinline__ void p0_prologue(Frame& F, const Args& a) {
    const int gw = F.vcu * NWAVES + F.wave, NGW = F.G * NWAVES, lane = F.lane;
    {
        LAS float* scr = (LAS float*)(F.lds + F.wave * 16384);
        int it = gw;
        if (it < NITEMS) {
            TItem cur = p0_decode(a, F.ws, it, lane); float x[32]; p0_load(cur, x, lane);
            for (;;) {
#pragma unroll
                for (int i = 0; i < 32; ++i) scr[(2 * i + (lane >> 5)) * 33 + (lane & 31)] = x[i];
                const int nit = it + NGW; const bool hn = nit < NITEMS; TItem nxt = cur;
                if (hn) { nxt = p0_decode(a, F.ws, nit, lane); p0_load(nxt, x, lane); }
                LDS_WAIT(); asm volatile("" ::: "memory");
                const int c = lane & 7;
#pragma unroll
                for (int j = 0; j < 4; ++j) { const int n = (lane >> 3) + 8 * j; const LAS float* s = scr + (8 * c) * 33 + n;
                    v4u o; o.x = pk2(s[0 * 33], s[1 * 33]); o.y = pk2(s[2 * 33], s[3 * 33]); o.z = pk2(s[4 * 33], s[5 * 33]); o.w = pk2(s[6 * 33], s[7 * 33]);
                    *(GAS v4u*)(cur.WT + (size_t)(cur.dst_row0 + n) * cur.K + cur.k0 + 8 * c) = o; }
                LDS_WAIT(); asm volatile("" ::: "memory");
                if (!hn) break;
                cur = nxt; it = nit;
            }
        }
    }
    for (int m = gw; m < M; m += NGW) rms_row_to_bf16(a.x + (size_t)m * D, a.g_mix, WSP(bf16, WS_XN) + (size_t)m * D, F.lane);
    for (int m = gw; m < MROWS; m += NGW) rms_row_to_bf16(a.mem + (size_t)m * D, a.g_mem, WSP(bf16, WS_MEMN) + (size_t)m * D, F.lane);
    for (int m = gw; m < M; m += NGW) {
        if (F.lane < 48) {
            const bool mla = F.lane < 16; const int i = mla ? F.lane : F.lane - 16;
            const float inv = powf(10000.f, mla ? -(float)(2 * i) / 32.f : -(float)(2 * i) / 64.f);
            const float ang = (float)a.pos[m] * inv;
            float sn, cs; sincosf(ang, &sn, &cs);
            float* dst = mla ? WSP(float, WS_RMLA) + ((size_t)m * 16 + i) * 2 : WSP(float, WS_RSWA) + ((size_t)m * 32 + i) * 2;
            dst[0] = cs; dst[1] = sn;
        }
    }
}

__device__ __forceinline__ void p7_router(Frame& F, const Args& a) {
    const int lane = F.lane, wave = F.wave, tid = F.tid;
    LAS float* hs = (LAS float*)(F.lds) + wave * 4096;
    LAS int* e_arr = (LAS int*)(F.lds + SMALL_OFF);
    LAS float* w_arr = (LAS float*)(e_arr + 256);
    LAS int* cnt_l = e_arr + 512; LAS int* base_l = e_arr + 544;
    const float* H = WSP(float, WS_H);
    for (int c = F.vcu; c < NCHUNK; c += F.G) {
        for (int r = 0; r < 2; ++r) {
            const int tl0 = wave * 8 + r * 4;
#pragma unroll
            for (int q = 0; q < 4; ++q) {
                const int t = c * 64 + tl0 + q;
                const GAS f32x4* xr = (const GAS f32x4*)(H + (size_t)t * D) + lane; const GAS f32x4* gr = (const GAS f32x4*)a.g_ffn + lane;
                f32x4 v[4]; float s = 0.f;
#pragma unroll
                for (int j = 0; j < 4; ++j) { v[j] = xr[64 * j]; s += (v[j].x * v[j].x + v[j].y * v[j].y) + (v[j].z * v[j].z + v[j].w * v[j].w); }
                const float rstd = 1.f / sqrtf(wave_sum(s) * (1.f / D) + EPS);
                GAS unsigned long long* o8 = (GAS unsigned long long*)(WSP(bf16, WS_XN) + (size_t)t * D) + lane;
#pragma unroll
                for (int j = 0; j < 4; ++j) { const f32x4 gg = gr[64 * j]; f32x4 y; y.x = v[j].x * rstd * gg.x; y.y = v[j].y * rstd * gg.y; y.z = v[j].z * rstd * gg.z; y.w = v[j].w * rstd * gg.w;
                    o8[64 * j] = (unsigned long long)pk2(y.x, y.y) | ((unsigned long long)pk2(y.z, y.w) << 32);
                    *(LAS f32x4*)(hs + q * 1024 + 4 * (64 * j + lane)) = y; }
            }
            LDS_WAIT(); asm volatile("" ::: "memory");
            const int e = lane & 31, half = lane >> 5;
            float acc[4] = {0.f, 0.f, 0.f, 0.f};
            const float* wr = a.w_router + (size_t)(half * 512) * NE + e;
            const LAS float* hh = hs + half * 512;
#pragma unroll 4
            for (int kk = 0; kk < 512; ++kk) { const float w = wr[(size_t)kk * NE];
#pragma unroll
                for (int q = 0; q < 4; ++q) acc[q] += hh[q * 1024 + kk] * w; }
            const float br = a.b_router[e];
#pragma unroll
            for (int q = 0; q < 4; ++q) {
                float lg = acc[q] + __shfl_xor(acc[q], 32) + br;
                float tv[4]; int ti[4];
#pragma unroll
                for (int k = 0; k < 4; ++k) {
                    float v = lg; int idx = e;
#pragma unroll
                    for (int o = 1; o < 32; o <<= 1) { const float ov = __shfl_xor(v, o); const int oi = __shfl_xor(idx, o); if (ov > v || (ov == v && oi < idx)) { v = ov; idx = oi; } }
                    tv[k] = v; ti[k] = idx; if (e == idx) lg = -INFINITY;
                }
                const float e1 = __expf(tv[1] - tv[0]), e2 = __expf(tv[2] - tv[0]), e3 = __expf(tv[3] - tv[0]); const float inv = 1.f / (1.f + e1 + e2 + e3);
                if (lane == 0) { const int tl = tl0 + q; const int t = c * 64 + tl;
                    int* te = WSP(int, WS_TKE) + (size_t)t * 4;
                    te[0] = ti[0]; te[1] = ti[1]; te[2] = ti[2]; te[3] = ti[3]; w_arr[tl * 4 + 0] = inv; w_arr[tl * 4 + 1] = e1 * inv; w_arr[tl * 4 + 2] = e2 * inv; w_arr[tl * 4 + 3] = e3 * inv;
                    e_arr[tl * 4 + 0] = ti[0]; e_arr[tl * 4 + 1] = ti[1]; e_arr[tl * 4 + 2] = ti[2]; e_arr[tl * 4 + 3] = ti[3]; }
            }
            LDS_WAIT(); asm volatile("" ::: "memory");
        }
        __syncthreads();
        int rk = 0;
        if (tid < 256) { const int e = e_arr[tid]; for (int j = 0; j < tid; ++j) rk += (e_arr[j] == e) ? 1 : 0; }
        else if (tid < 256 + NE) { const int e = tid - 256; int n = 0; for (int j = 0; j < 256; ++j) n += (e_arr[j] == e) ? 1 : 0; cnt_l[e] = n; }
        __syncthreads();
        if (tid < NE) base_l[tid] = (int)__hip_atomic_fetch_add((unsigned*)(F.ctl + CW_ECNT + 64 * tid), (unsigned)cnt_l[tid], __ATOMIC_RELAXED, __HIP_MEMORY_SCOPE_AGENT);
        __syncthreads();
        if (tid < 256) { const int e = e_arr[tid], pos = base_l[e] + rk, t = c * 64 + (tid >> 2);
            WSP(int, WS_TOK)[e * 16384 + pos] = t; WSP(float, WS_TOKW)[e * 16384 + pos] = w_arr[tid]; WSP(int, WS_TKR)[(size_t)t * 4 + (tid & 3)] = pos; }
        __syncthreads();
    }
}

__device__ __forceinline__ void moe_tables(Frame& F) {
    LAS int* tb = (LAS int*)(F.lds + SMALL_OFF);
    __syncthreads();
    if (F.tid < NE) tb[F.tid] = (int)__hip_atomic_load((unsigned*)(F.ctl + CW_ECNT + 64 * F.tid), __ATOMIC_RELAXED, __HIP_MEMORY_SCOPE_AGENT);
    __syncthreads();
    if (F.tid == 0) { int ps = 0; for (int e = 0; e < NE; ++e) { tb[32 + e] = ps; const int nt = (tb[e] + 255) >> 8; for (int j = 0; j < nt; ++j) tb[96 + ps + j] = e; ps += nt; } tb[64] = ps; }
    __syncthreads();
}
__device__ __forceinline__ void p11_combine(Frame& F, const Args& a) {
    const int gw = F.vcu * NWAVES + F.wave, NGW = F.G * NWAVES, lane = F.lane;
    const bf16* Y = WSP(bf16, WS_PROJ);
    moe_tables(F); const LAS int* tb = (const LAS int*)(F.lds + SMALL_OFF);
    for (int m = gw; m < M; m += NGW) {
        const GAS f32x4* xr = (const GAS f32x4*)(WSP(float, WS_H) + (size_t)m * D) + lane; const GAS f32x4* gr = (const GAS f32x4*)a.g_final + lane;
        f32x4 v[4];
#pragma unroll
        for (int j = 0; j < 4; ++j) v[j] = xr[64 * j];
#pragma unroll
        for (int k = 0; k < 4; ++k) { const int row = (tb[32 + WSP(int, WS_TKE)[(size_t)m * 4 + k]] << 8) + WSP(int, WS_TKR)[(size_t)m * 4 + k]; const GAS v2u* yr = (const GAS v2u*)(Y + (size_t)row * D) + lane;
#pragma unroll
            for (int j = 0; j < 4; ++j) { const v2u w = yr[64 * j]; v[j].x += bflo(w.x); v[j].y += bfhi(w.x); v[j].z += bflo(w.y); v[j].w += bfhi(w.y); } }
        float s = 0.f;
#pragma unroll
        for (int j = 0; j < 4; ++j) s += (v[j].x * v[j].x + v[j].y * v[j].y) + (v[j].z * v[j].z + v[j].w * v[j].w);
        const float rstd = 1.f / sqrtf(wave_sum(s) * (1.f / D) + EPS);
        GAS f32x4* o = (GAS f32x4*)(a.out + (size_t)m * D) + lane;
#pragma unroll
        for (int j = 0; j < 4; ++j) { const f32x4 gg = gr[64 * j]; f32x4 y; y.x = v[j].x * rstd * gg.x; y.y = v[j].y * rstd * gg.y; y.z = v[j].z * rstd * gg.z; y.w = v[j].w * rstd * gg.w;
            if (PROBE_SEL >= 0) {
                const unsigned long long* stp = (const unsigned long long*)(F.ws + WS_CTL + 512 * 1024);
                constexpr int kp = PROBE_SEL == 0 ? -1 : (PROBE_SEL == 3 ? 1 : PROBE_SEL - 1);
                const unsigned long long t0 = stp[1 + kp], t1 = stp[1 + (PROBE_SEL >= 0 ? PROBE_SEL : 0)], ta = stp[32 + (PROBE_SEL >= 0 ? PROBE_SEL : 0)];
                const float sc = 1.02f + (float)(t1 - t0) * (0.01f / PROBE_DIV); y.x *= sc; y.y *= sc; y.z *= sc; y.w *= sc;
                if (m == 0 && j == 0 && lane == 0) y.x += 100.f + (float)(ta - t0) * 0.01f; }
            o[64 * j] = y; }
    }
}

namespace att {
using s16x4  = __attribute__((ext_vector_type(4))) short;
using f32x16 = __attribute__((ext_vector_type(16))) float;
using u32x4  = __attribute__((ext_vector_type(4))) unsigned;
#define KSWZ(row, colB) ((row) * 256 + ((colB) ^ (((row) & 7) << 4)))
#define SBAR() __builtin_amdgcn_sched_barrier(0)
constexpr float THR2 = 8.f;
__device__ __forceinline__ int crow(int r, int hi) { return (r & 3) + 8 * (r >> 2) + 4 * hi; }
__device__ __forceinline__ unsigned cvtpk(float lo, float hi) { unsigned r; asm volatile("v_cvt_pk_bf16_f32 %0, %1, %2" : "=v"(r) : "v"(lo), "v"(hi)); return r; }
template <int NCB> __device__ __forceinline__ int v_st(int k, int c) { const int kk = (k & ~0xC) | ((k & 4) << 1) | ((k & 8) >> 1); return ((kk >> 3) * NCB + (c >> 5)) * 512 + ((kk & 7) * 32 + (c & 31)) * 2; }
__device__ __forceinline__ int v_rd_base(int lane) { return ((lane & 3) << 3) | (((lane >> 2) & 3) << 6) | (((lane >> 4) & 1) << 5) | (((lane >> 5) & 1) << 8); }
template <int OFF> __device__ __forceinline__ s16x4 tr_read(int vb) { s16x4 r; asm volatile("ds_read_b64_tr_b16 %0, %1 offset:%2" : "=&v"(r) : "v"(vb), "i"(OFF) : "memory"); return r; }

template <int MODE> __device__ __forceinline__ void partialSM(f32x16& p0, f32x16& p1, float& m_reg, float& mn, float& alpha, bool domask, int kb, int qrow, int hi) {
    if (MODE != 2 && domask) {
#pragma unroll
        for (int r = 0; r < 16; ++r) { const int k0 = kb + crow(r, hi), k1 = k0 + 32;
            if (k0 > qrow || (MODE == 1 && k0 < qrow - 127)) p0[r] = -INFINITY;
            if (k1 > qrow || (MODE == 1 && k1 < qrow - 127)) p1[r] = -INFINITY; }
    }
    float pmax = p0[0];
#pragma unroll
    for (int r = 1; r < 16; ++r) pmax = fmaxf(pmax, p0[r]);
#pragma unroll
    for (int r = 0; r < 16; ++r) pmax = fmaxf(pmax, p1[r]);
    { auto rr = __builtin_amdgcn_permlane32_swap(__float_as_uint(pmax), __float_as_uint(pmax), false, false); pmax = fmaxf(__uint_as_float(rr[0]), __uint_as_float(rr[1])); }
    if (__builtin_expect(__all(pmax - m_reg <= THR2), 1)) { mn = m_reg; alpha = 1.f; }
    else { mn = fmaxf(m_reg, pmax); alpha = __builtin_amdgcn_exp2f(m_reg - mn); m_reg = mn; }
#pragma unroll
    for (int r = 0; r < 16; ++r) p0[r] = p0[r] - mn;
#pragma unroll
    for (int r = 0; r < 16; ++r) p1[r] = p1[r] - mn;
#pragma unroll
    for (int r = 0; r < 16; ++r) p0[r] = __builtin_amdgcn_exp2f(p0[r]);
}
__device__ __forceinline__ void finishSM(f32x16& p0, f32x16& p1, float alpha, float& l_reg, bf16x8& pa0, bf16x8& pa1, bf16x8& pa2, bf16x8& pa3) {
#pragma unroll
    for (int r = 0; r < 16; ++r) p1[r] = __builtin_amdgcn_exp2f(p1[r]);
    float ps = 0;
#pragma unroll
    for (int r = 0; r < 16; ++r) ps += p0[r];
#pragma unroll
    for (int r = 0; r < 16; ++r) ps += p1[r];
    { auto rr = __builtin_amdgcn_permlane32_swap(__float_as_uint(ps), __float_as_uint(ps), false, false); ps = __uint_as_float(rr[0]) + __uint_as_float(rr[1]); }
    l_reg = l_reg * alpha + ps;
#define PK4(P, BASE, OUT) do { unsigned a0 = cvtpk(P[BASE + 0], P[BASE + 1]), a1 = cvtpk(P[BASE + 2], P[BASE + 3]);   \
    unsigned b0 = cvtpk(P[BASE + 4], P[BASE + 5]), b1 = cvtpk(P[BASE + 6], P[BASE + 7]);                              \
    auto r0 = __builtin_amdgcn_permlane32_swap(a0, b0, false, false); auto r1 = __builtin_amdgcn_permlane32_swap(a1, b1, false, false); \
    u32x4 w = {r0[0], r1[0], r0[1], r1[1]}; OUT = *reinterpret_cast<bf16x8*>(&w); } while (0)
    PK4(p0, 0, pa0); PK4(p0, 8, pa1); PK4(p1, 0, pa2); PK4(p1, 8, pa3);
#undef PK4
}
template <int ND0> __device__ __forceinline__ void qkt(f32x16& p0, f32x16& p1, const char* Ks, const bf16x8* qr, int r32, int hi) {
    p0 = f32x16{}; p1 = f32x16{};
#pragma unroll
    for (int d0 = 0; d0 < ND0; ++d0) { const int cb = (d0 * 16 + hi * 8) * 2;
        const bf16x8 b0 = *reinterpret_cast<const bf16x8*>(Ks + KSWZ(r32, cb));
        const bf16x8 b1 = *reinterpret_cast<const bf16x8*>(Ks + KSWZ(32 + r32, cb));
        p0 = __builtin_amdgcn_mfma_f32_32x32x16_bf16(b0, qr[d0], p0, 0, 0, 0);
        p1 = __builtin_amdgcn_mfma_f32_32x32x16_bf16(b1, qr[d0], p1, 0, 0, 0); }
}
template <int NCB, int D0> __device__ __forceinline__ void pv_one(f32x16& od, int vb, bf16x8 pa0, bf16x8 pa1, bf16x8 pa2, bf16x8 pa3) {
    constexpr int KS = 2 * NCB * 512, HF = NCB * 512;
    const s16x4 l0 = tr_read<D0 * 512 + 0 * KS>(vb), h0 = tr_read<D0 * 512 + 0 * KS + HF>(vb), l1 = tr_read<D0 * 512 + 1 * KS>(vb), h1 = tr_read<D0 * 512 + 1 * KS + HF>(vb);
    const s16x4 l2 = tr_read<D0 * 512 + 2 * KS>(vb), h2 = tr_read<D0 * 512 + 2 * KS + HF>(vb), l3 = tr_read<D0 * 512 + 3 * KS>(vb), h3 = tr_read<D0 * 512 + 3 * KS + HF>(vb);
    asm volatile("s_waitcnt lgkmcnt(0)" ::: "memory"); SBAR();
#define PK(L, H) (bf16x8){L[0], L[1], L[2], L[3], H[0], H[1], H[2], H[3]}
    od = __builtin_amdgcn_mfma_f32_32x32x16_bf16(pa0, PK(l0, h0), od, 0, 0, 0);
    od = __builtin_amdgcn_mfma_f32_32x32x16_bf16(pa1, PK(l1, h1), od, 0, 0, 0);
    od = __builtin_amdgcn_mfma_f32_32x32x16_bf16(pa2, PK(l2, h2), od, 0, 0, 0);
    od = __builtin_amdgcn_mfma_f32_32x32x16_bf16(pa3, PK(l3, h3), od, 0, 0, 0);
#undef PK
}
template <int NCB> __device__ __forceinline__ void pv_all(f32x16* o, int vb, bf16x8 pa0, bf16x8 pa1, bf16x8 pa2, bf16x8 pa3) {
    pv_one<NCB, 0>(o[0], vb, pa0, pa1, pa2, pa3); pv_one<NCB, 1>(o[1], vb, pa0, pa1, pa2, pa3);
    if constexpr (NCB == 4) { pv_one<NCB, 2>(o[2], vb, pa0, pa1, pa2, pa3); pv_one<NCB, 3>(o[3], vb, pa0, pa1, pa2, pa3); }
}

template <int MODE> __device__ __forceinline__ void attn_unit(const Args& a, int b, int h, int qb, char* lds) {
    constexpr int DQK = MODE == 0 ? 96 : (MODE == 1 ? 64 : 128), DV = MODE == 2 ? 128 : 64, ND0 = DQK / 16, NCB = DV / 32;
    constexpr int SHM_V = 64 * DV * 2, SHM_K = 64 * 256;
    unsigned char* ws = a.ws;
    const bf16* PROJ = (const bf16*)(ws + WS_PROJ); const bf16* KVMLA = (const bf16*)(ws + WS_KVMLA); const bf16* KVMEM = (const bf16*)(ws + WS_KVMEM); const bf16* QMLA = (const bf16*)(ws + WS_QMLA);
    const int tid = threadIdx.x, wid = tid >> 6, lane = tid & 63, r32 = lane & 31, hi = lane >> 5;
    char* V_lds = lds; char* K_lds = lds + 2 * SHM_V;
    float* wsf = (float*)(lds + 65536) + wid * 64; float* li_l = wsf; float* al_l = wsf + 32;
    const int q0 = qb * 256, qrow = q0 + wid * 32 + r32; const size_t m = (size_t)b * SEQ + qrow;
    float m_reg = -1e30f, l_reg = 0.f; f32x16 o[NCB]; bf16x8 qr[ND0];
#pragma unroll
    for (int d = 0; d < NCB; ++d) o[d] = f32x16{};
    {
        const bf16* Qw = MODE == 0 ? QMLA + m * 768 + h * 96 + hi * 8 : (MODE == 1 ? PROJ + m * LDP + PC_QS + h * 64 + hi * 8 : PROJ + m * LDP + PC_QX + h * 128 + hi * 8);
#pragma unroll
        for (int d0 = 0; d0 < ND0; ++d0) qr[d0] = *reinterpret_cast<const bf16x8*>(Qw + d0 * 16);
    }
    const int key0 = MODE == 1 ? (q0 >= 128 ? q0 - 128 : 0) : 0;
    const int NT = MODE == 0 ? 4 * (qb + 1) : (MODE == 1 ? (qb == 0 ? 4 : 6) : 4);
    const int sr8 = tid >> 3, sc8 = tid & 7;
    const int sr4 = (tid >> 2) & 63, sc4 = tid & 3;
    const int sr = tid >> 4, sc = (tid & 15) * 8;
    const size_t krow0 = (size_t)b * (MODE == 2 ? MEML : SEQ) + key0;
    const int vb0 = (int)(uintptr_t)V_lds + v_rd_base(lane);
    struct { bf16x8 ks0, ks1, vs0, vs1; } st_[2];
#define SLOAD(i, t) do { const size_t kr_ = krow0 + (size_t)(t) * 64;                                                                      \
        if constexpr (MODE == 0) { st_[i].ks0 = *reinterpret_cast<const bf16x8*>(KVMLA + (kr_ + sr8) * 1024 + h * 128 + sc8 * 8);          \
            st_[i].vs0 = *reinterpret_cast<const bf16x8*>(KVMLA + (kr_ + sr8) * 1024 + h * 128 + 64 + sc8 * 8);                           \
            if (tid < 256) st_[i].ks1 = *reinterpret_cast<const bf16x8*>(PROJ + (kr_ + sr4) * LDP + PC_KR + sc4 * 8); }                   \
        else if constexpr (MODE == 1) { st_[i].ks0 = *reinterpret_cast<const bf16x8*>(PROJ + (kr_ + sr8) * LDP + PC_KS + (h >> 2) * 64 + sc8 * 8); \
            st_[i].vs0 = *reinterpret_cast<const bf16x8*>(PROJ + (kr_ + sr8) * LDP + PC_VS + (h >> 2) * 64 + sc8 * 8); }                  \
        else { st_[i].ks0 = *reinterpret_cast<const bf16x8*>(KVMEM + (kr_ + sr) * 1024 + h * 128 + sc);                                    \
            st_[i].ks1 = *reinterpret_cast<const bf16x8*>(KVMEM + (kr_ + 32 + sr) * 1024 + h * 128 + sc);                                  \
            st_[i].vs0 = *reinterpret_cast<const bf16x8*>(KVMEM + (kr_ + sr) * 1024 + 512 + h * 128 + sc);                                \
            st_[i].vs1 = *reinterpret_cast<const bf16x8*>(KVMEM + (kr_ + 32 + sr) * 1024 + 512 + h * 128 + sc); } } while (0)
#define SWRITE(bf, i) do {                                                                                                                 \
        if constexpr (MODE == 0) { *(bf16x8*)(K_lds + (bf) * SHM_K + KSWZ(sr8, sc8 * 16)) = st_[i].ks0;                                    \
            *(bf16x8*)(V_lds + (bf) * SHM_V + v_st<NCB>(sr8, sc8 * 8)) = st_[i].vs0;                                                       \
            if (tid < 256) *(bf16x8*)(K_lds + (bf) * SHM_K + KSWZ(sr4, 128 + sc4 * 16)) = st_[i].ks1; }                                    \
        else if constexpr (MODE == 1) { *(bf16x8*)(K_lds + (bf) * SHM_K + KSWZ(sr8, sc8 * 16)) = st_[i].ks0;                               \
            *(bf16x8*)(V_lds + (bf) * SHM_V + v_st<NCB>(sr8, sc8 * 8)) = st_[i].vs0; }                                                     \
        else { *(bf16x8*)(K_lds + (bf) * SHM_K + KSWZ(sr, sc * 2)) = st_[i].ks0; *(bf16x8*)(K_lds + (bf) * SHM_K + KSWZ(32 + sr, sc * 2)) = st_[i].ks1; \
            *(bf16x8*)(V_lds + (bf) * SHM_V + v_st<NCB>(sr, sc)) = st_[i].vs0; *(bf16x8*)(V_lds + (bf) * SHM_V + v_st<NCB>(32 + sr, sc)) = st_[i].vs1; } } while (0)
#define SWAIT() do { if constexpr (MODE == 2) asm volatile("s_waitcnt vmcnt(4)" ::: "memory"); else asm volatile("s_waitcnt vmcnt(2)" ::: "memory"); } while (0)
#define RESC(al) do { if (__any((al) < 1.f)) { if (hi == 0) al_l[r32] = (al); asm volatile("s_waitcnt lgkmcnt(0)" ::: "memory");            \
        _Pragma("unroll") for (int d = 0; d < NCB; ++d) _Pragma("unroll") for (int r = 0; r < 16; ++r) o[d][r] *= al_l[crow(r, hi)]; } } while (0)
#define DOMASK(t) (MODE == 1 || (MODE == 0 && (t) >= NT - 4))
    f32x16 pA0, pA1, pB0, pB1; float mnA, mnB, alA, alB; bf16x8 pa0, pa1, pa2, pa3;
    SLOAD(0, 0); asm volatile("s_waitcnt vmcnt(0)" ::: "memory"); SWRITE(0, 0); __syncthreads();
    qkt<ND0>(pA0, pA1, K_lds, qr, r32, hi); partialSM<MODE>(pA0, pA1, m_reg, mnA, alA, DOMASK(0), key0, qrow, hi);
    SLOAD(1, 1); if (2 < NT) SLOAD(0, 2);
    SWAIT(); SWRITE(1, 1); __syncthreads();
    for (int j = 1; j + 1 < NT; j += 2) {
        SBAR(); qkt<ND0>(pB0, pB1, K_lds + SHM_K, qr, r32, hi);
        finishSM(pA0, pA1, alA, l_reg, pa0, pa1, pa2, pa3); SBAR();
        if (j + 2 < NT) SLOAD(1, j + 2); SBAR();
        pv_all<NCB>(o, vb0, pa0, pa1, pa2, pa3); partialSM<MODE>(pB0, pB1, m_reg, mnB, alB, DOMASK(j), key0 + 64 * j, qrow, hi);
        __syncthreads(); SWAIT(); SWRITE(0, 0);
        RESC(alB); __syncthreads();
        SBAR(); qkt<ND0>(pA0, pA1, K_lds, qr, r32, hi);
        finishSM(pB0, pB1, alB, l_reg, pa0, pa1, pa2, pa3); SBAR();
        if (j + 3 < NT) SLOAD(0, j + 3); SBAR();
        pv_all<NCB>(o, vb0 + SHM_V, pa0, pa1, pa2, pa3); partialSM<MODE>(pA0, pA1, m_reg, mnA, alA, DOMASK(j + 1), key0 + 64 * (j + 1), qrow, hi);
        __syncthreads(); SWAIT(); if (j + 2 < NT) SWRITE(1, 1);
        RESC(alA); __syncthreads();
    }
    SBAR(); qkt<ND0>(pB0, pB1, K_lds + SHM_K, qr, r32, hi);
    finishSM(pA0, pA1, alA, l_reg, pa0, pa1, pa2, pa3); SBAR();
    pv_all<NCB>(o, vb0, pa0, pa1, pa2, pa3); partialSM<MODE>(pB0, pB1, m_reg, mnB, alB, DOMASK(NT - 1), key0 + 64 * (NT - 1), qrow, hi);
    __syncthreads(); RESC(alB);
    finishSM(pB0, pB1, alB, l_reg, pa0, pa1, pa2, pa3); SBAR();
    pv_all<NCB>(o, vb0 + SHM_V, pa0, pa1, pa2, pa3);
    if constexpr (MODE == 1) l_reg += __builtin_amdgcn_exp2f(a.sinks[h] * LOG2E - m_reg);
    if (hi == 0) li_l[r32] = l_reg; asm volatile("s_waitcnt lgkmcnt(0)" ::: "memory");
    float rli[16];
#pragma unroll
    for (int r = 0; r < 16; ++r) rli[r] = __builtin_amdgcn_rcpf(li_l[crow(r, hi)]);
    __syncthreads();
    bf16* stg = (bf16*)(lds + wid * (32 * DV * 2));
#pragma unroll
    for (int r = 0; r < 16; ++r) { const int orow = crow(r, hi);
#pragma unroll
        for (int d0 = 0; d0 < NCB; ++d0) stg[orow * DV + d0 * 32 + r32] = (bf16)f2bf(o[d0][r] * rli[r]); }
    asm volatile("s_waitcnt lgkmcnt(0)" ::: "memory");
    bf16* Ow = (bf16*)(ws + WS_ATT) + ((size_t)b * SEQ + q0 + wid * 32) * 1536 + (MODE == 0 ? h * 64 : (MODE == 1 ? 512 + h * 64 : 1024 + h * 128));
    constexpr int CPR = DV / 8;
#pragma unroll
    for (int i = 0; i < (32 * CPR) / 64; ++i) { const int idx = i * 64 + lane, row = idx / CPR, ch = idx % CPR;
        const u32x4 v = *(const u32x4*)(stg + row * DV + ch * 8); *(u32x4*)(Ow + (size_t)row * 1536 + ch * 8) = v; }
    asm volatile("s_waitcnt lgkmcnt(0)" ::: "memory");
    __syncthreads();
#undef SLOAD
#undef SWRITE
#undef SWAIT
#undef RESC
#undef DOMASK
}
__device__ __forceinline__ void attn_phase(const Args& a, int vcu, int G, char* lds) {
    constexpr int D0 = (DUP_MASK >> 12) & 1, D1 = (DUP_MASK >> 13) & 1, D2 = (DUP_MASK >> 14) & 1;
    for (int k = 0;; ++k) { const int kk = k >> D0, i = vcu + (kk >> 1) * G; if (i >= 256) break; const int bh = i >> 4, s = i & 15;
        attn_unit<0>(a, bh >> 3, bh & 7, (kk & 1) ? s : 31 - s, lds); }
    for (int k = 0;; ++k) { const int kk = k >> D1, i = vcu + (kk >> 1) * G; if (i >= 256) break; const int su = 2 * i + (kk & 1);
        attn_unit<1>(a, su >> 8, (su >> 5) & 7, su & 31, lds); }
    for (int k = 0;; ++k) { const int i = vcu + (k >> D2) * G; if (i >= 256) break; attn_unit<2>(a, i >> 7, (i >> 5) & 3, i & 31, lds); }
}
#undef KSWZ
#undef SBAR
}

template <int K> __device__ __forceinline__ void run_phase(Frame& F, const Args& args, unsigned char* lds) {
    const int bx = (int)blockIdx.x;
    if constexpr (K == 0) p0_prologue(F, args);
    if constexpr (K == 1) {
        { pg8::Gemm g{WSP(bf16, WS_MEMN), WSP(bf16, WS_WMKV), MROWS, 1024, 1024, 1024, 1024}; pg8::TailOrder S{4, 8, F.G, bx}; pg8::EpiPlain E{WSP(bf16, WS_KVMEM), 1024, 1.f};
          pg8::gemm_phase<pg8::EpiPlain, pg8::TailOrder, true, true>(F.lds, g, S, E); }
        { pg8::Gemm g{WSP(bf16, WS_XN), WSP(bf16, WS_WIN), M, LDP, 1024, 1024, 1024}; pg8::StaticOrder S; S.init(M, LDP, F.G, bx);
          pg8::EpiProj E{WSP(bf16, WS_PROJ), args.b_gate, WSP(float, WS_RSWA), WSP(float, WS_RMLA), WSP(float, WS_SSQQ), WSP(float, WS_SSQKV), C_XA, C_SWA};
          pg8::gemm_phase<pg8::EpiProj, pg8::StaticOrder, true, true>(F.lds, g, S, E); } }
    if constexpr (K == 3) {
        { pg8::Gemm g{WSP(bf16, WS_PROJ) + PC_CQ, WSP(bf16, WS_WUQ), M, 768, 256, LDP, 256}; pg8::SimpleOrder S{3, 192, F.G, bx}; pg8::EpiQmla E{WSP(bf16, WS_QMLA), WSP(float, WS_SSQQ), WSP(float, WS_RMLA), C_MLA};
          pg8::gemm_phase<pg8::EpiQmla, pg8::SimpleOrder, true, true>(F.lds, g, S, E); }
        { pg8::Gemm g{WSP(bf16, WS_PROJ) + PC_CKV, WSP(bf16, WS_WUKV), M, 1024, 128, LDP, 128}; pg8::SimpleOrder S{4, 256, F.G, bx}; pg8::EpiRowScale E{WSP(bf16, WS_KVMLA), 1024, WSP(float, WS_SSQKV), 1.f / 128.f};
          pg8::gemm_phase<pg8::EpiRowScale, pg8::SimpleOrder, true, true>(F.lds, g, S, E); } }
    if constexpr (K == 4) att::attn_phase(args, F.vcu, F.G, (char*)lds);
    if constexpr (K == 5) {
        pg8::Gemm g{WSP(bf16, WS_ATT), WSP(bf16, WS_WO3), M, 3072, 512, 1536, 512}; pg8::Gate3Order S{F.G, bx}; pg8::EpiGate3 E{WSP(bf16, WS_PROJ), WSP(float, WS_MERGED), WSP(bf16, WS_MERGEDB)};
        pg8::gemm_phase<pg8::EpiGate3, pg8::Gate3Order, true, true>(F.lds, g, S, E); }
    if constexpr (K == 6) {
        pg8::Gemm g{WSP(bf16, WS_MERGEDB), WSP(bf16, WS_WOUT), M, 1024, 1024, 1024, 1024}; pg8::SimpleOrder S{4, 256, F.G, bx}; pg8::EpiResF32 E{args.x, WSP(float, WS_H)};
        pg8::gemm_phase<pg8::EpiResF32, pg8::SimpleOrder, true, true>(F.lds, g, S, E); }
    if constexpr (K == 7) p7_router(F, args);
    if constexpr (K == 9) {
        moe_tables(F); const LAS int* tb = (const LAS int*)(F.lds + SMALL_OFF);
        pg8::Gemm g{WSP(bf16, WS_XN), WSP(bf16, WS_WGU), M, NE * 2048, 1024, 1024, 1024}; pg8::MoeOrder<8> S{tb, WSP(int, WS_TOK), F.G, bx}; pg8::EpiSwiglu E{WSP(bf16, WS_HDN), args.b_gu};
        pg8::gemm_phase<pg8::EpiSwiglu, pg8::MoeOrder<8>, true, true, true>(F.lds, g, S, E); }
    if constexpr (K == 10) {
        moe_tables(F); const LAS int* tb = (const LAS int*)(F.lds + SMALL_OFF);
        pg8::Gemm g{WSP(bf16, WS_HDN), WSP(bf16, WS_WDN), RMAX, NE * 1024, 1024, 1024, 1024}; pg8::MoeOrder<4> S{tb, WSP(int, WS_TOK), F.G, bx}; pg8::EpiDown E{WSP(bf16, WS_PROJ), args.b_dn, WSP(float, WS_TOKW), tb};
        pg8::gemm_phase<pg8::EpiDown, pg8::MoeOrder<4>, true, true>(F.lds, g, S, E); }
    if constexpr (K == 11) p11_combine(F, args);
}

__global__ void __launch_bounds__(NWAVES * 64, 2) fwd(Args args) {
    extern __shared__ __attribute__((aligned(16))) unsigned char lds[];
    Frame F;
    F.lds = (LAS unsigned char*)lds;
    F.MISC = (volatile LAS unsigned*)(F.lds + MISC_OFF);
    F.tid = threadIdx.x; F.lane = F.tid & 63; F.wave = __builtin_amdgcn_readfirstlane(F.tid >> 6);
    F.G = gridDim.x; { const int bx = blockIdx.x; F.vcu = (F.G % 8 == 0) ? (bx % 8) * (F.G / 8) + bx / 8 : bx; }
    F.ws = args.ws; F.ctl = (gu32*)(args.ws + WS_CTL);
    for (int u = F.tid; u < (LDS_BYTES - LDSCTL_OFF) / 4; u += NWAVES * 64) ((LAS unsigned*)(F.lds + LDSCTL_OFF))[u] = 0u;
    __syncthreads();
    const int lo = args.ph_lo, hi = args.ph_hi;
    XcdBarrier bar; bar.bar = (unsigned*)(F.ctl + CW_BAR) + lo * XCD_BAR_WORDS; bar.x = 0; bar.st = nullptr;
    unsigned bepoch = 0u;
    if (hi - lo > 1 && !BAR_FLAT) bar = xcd_barrier_post((unsigned*)(F.ctl + CW_BAR) + lo * XCD_BAR_WORDS, F.MISC + 8);
#define IN(k) (lo <= (k) && (k) < hi)
#define PH(k, nx) if (IN(k)) { run_phase<k>(F, args, lds); if (DUP_MASK & (1u << (k))) run_phase<k>(F, args, lds); \
        if (PROBE_SEL >= 0 && F.tid == 0) __hip_atomic_fetch_max(stp + 32 + (k), (unsigned long long)__builtin_amdgcn_s_memrealtime(), __ATOMIC_RELAXED, __HIP_MEMORY_SCOPE_AGENT); \
        if (IN(nx)) { if (BAR_FLAT) flat_barrier(bar.bar, bepoch); else xcd_barrier(bar); } \
        if (PROBE_SEL >= 0 && F.tid == 0 && blockIdx.x == 0) __hip_atomic_store(stp + 1 + (k), (unsigned long long)__builtin_amdgcn_s_memrealtime(), __ATOMIC_RELAXED, __HIP_MEMORY_SCOPE_AGENT); }
    unsigned long long* stp = (unsigned long long*)(args.ws + WS_CTL + 512 * 1024);
    if (PROBE_SEL >= 0 && F.tid == 0 && blockIdx.x == 0) __hip_atomic_store(stp, (unsigned long long)__builtin_amdgcn_s_memrealtime(), __ATOMIC_RELAXED, __HIP_MEMORY_SCOPE_AGENT);
    PH(0, 1)
    if (DUP_MASK & (1u << 16)) { for (int r = 0; r < 10; ++r) { if (BAR_FLAT) flat_barrier(bar.bar, bepoch); else xcd_barrier(bar); } }
    PH(1, 3) PH(3, 4) PH(4, 5) PH(5, 6) PH(6, 7) PH(7, 9) PH(9, 10) PH(10, 11) PH(11, 12)
#undef IN
#undef PH
}

static void launch_fwd(const Args& base, int lo, int hi, int grid, hipStream_t stream) {
    Args a = base; a.ph_lo = lo; a.ph_hi = hi;
    hipLaunchKernelGGL(fwd, dim3(grid), dim3(NWAVES * 64), LDS_BYTES, stream, a);
}
extern "C" void kernel_launch(void* const* d_in, const int* in_sizes, int n_in, void* d_out, int out_size, void* d_ws, size_t ws_size, hipStream_t stream) {
    static int grid = 0;
    if (grid == 0) {
        if (n_in != 25 || in_sizes[0] != M * D || out_size != M * D || ws_size < WS_END) { fprintf(stderr, "kernel_launch: unexpected shapes (n_in %d, ws %zu)\n", n_in, ws_size); grid = -1; return; }
        int dev = 0, cus = 0;
        if (hipGetDevice(&dev) != hipSuccess || hipDeviceGetAttribute(&cus, hipDeviceAttributeMultiprocessorCount, dev) != hipSuccess) { grid = -1; return; }
        if (hipFuncSetAttribute((const void*)fwd, hipFuncAttributeMaxDynamicSharedMemorySize, LDS_BYTES) != hipSuccess) { fprintf(stderr, "kernel_launch: hipFuncSetAttribute failed\n"); grid = -1; return; }
        int per_cu = 0;
        if (hipOccupancyMaxActiveBlocksPerMultiprocessor(&per_cu, (const void*)fwd, NWAVES * 64, LDS_BYTES) != hipSuccess || per_cu < 1) fprintf(stderr, "kernel_launch: occupancy query says %d\n", per_cu);
        (void)hipGetLastError();
        grid = cus;
    }
    if (grid < 0) return;
    (void)hipMemsetAsync((char*)d_ws + WS_CTL, 0, CTL_ZERO_BYTES, stream);
    Args a{};
    a.x = (const float*)d_in[0]; a.mem = (const float*)d_in[1]; a.pos = (const int*)d_in[2];
    a.g_mix = (const float*)d_in[3]; a.w_in = (const float*)d_in[4]; a.g_mla_q = (const float*)d_in[5]; a.w_uq = (const float*)d_in[6]; a.g_mla_kv = (const float*)d_in[7];
    a.w_ukv = (const float*)d_in[8]; a.w_mla_o = (const float*)d_in[9]; a.sinks = (const float*)d_in[10]; a.w_swa_o = (const float*)d_in[11]; a.g_mem = (const float*)d_in[12];
    a.w_mem_kv = (const float*)d_in[13]; a.w_xa_o = (const float*)d_in[14]; a.b_gate = (const float*)d_in[15]; a.w_out = (const float*)d_in[16]; a.g_ffn = (const float*)d_in[17];
    a.w_router = (const float*)d_in[18]; a.b_router = (const float*)d_in[19]; a.w_gu = (const float*)d_in[20]; a.b_gu = (const float*)d_in[21]; a.w_dn = (const float*)d_in[22];
    a.b_dn = (const float*)d_in[23]; a.g_final = (const float*)d_in[24];
    a.out = (float*)d_out; a.ws = (unsigned char*)d_ws;
    if (ONE_LAUNCH) launch_fwd(a, 0, 12, grid, stream);
    else { const int live[10] = {0, 1, 3, 4, 5, 6, 7, 9, 10, 11}; for (int i = 0; i < 10; ++i) launch_fwd(a, live[i], live[i] + 1, grid, stream); }
}
```
